# Optimizing an MI355X kernel written in HIP

```python
import math
import jax, jax.numpy as jnp
from jax import lax
import numpy as np

D_MODEL = 1024
BATCH = 16
SEQ = 2048
DEPTH = 2

GRID_W = 64
CTX_LEN = 256
N_MIXERS = 2
BLOCK = 128
WINDOW = 128
HEAD_DIM = 64
A_HEADS = D_MODEL // HEAD_DIM
A_KV_HEADS = max(1, A_HEADS // 8)
B_HEADS = D_MODEL // (2 * HEAD_DIM)
D_FF = 4 * D_MODEL
N_MOD = 6
ROPE_BASE = 10000.0
LN_EPS = 1e-5
SUBLN_EPS = 1e-5
NEG_INF = -1e30
DEEPNORM_ALPHA = (2 * DEPTH) ** 0.25
DEEPNORM_BETA = (8 * DEPTH) ** -0.25
N_A_LAYERS = (DEPTH + 1) // 2
N_B_LAYERS = DEPTH // 2

kernel_name = 'hybrid_swa_sink_diffattn_dit_block'


def layer_norm(x, g, b):
    x32 = x.astype(jnp.float32)
    mu = jnp.mean(x32, axis=-1, keepdims=True)
    var = jnp.mean(jnp.square(x32 - mu), axis=-1, keepdims=True)
    return ((x32 - mu) * lax.rsqrt(var + LN_EPS) * g + b).astype(x.dtype)


def axial_rope_tables(L):
    rows = L // GRID_W
    row = jnp.repeat(jnp.arange(rows, dtype=jnp.float32), GRID_W)
    col = jnp.tile(jnp.arange(GRID_W, dtype=jnp.float32), rows)
    n_freq = HEAD_DIM // 4
    inv = ROPE_BASE ** (-jnp.arange(n_freq, dtype=jnp.float32) / n_freq)
    ang = jnp.concatenate([row[:, None] * inv, col[:, None] * inv], axis=-1)
    return jnp.cos(ang), jnp.sin(ang)


def apply_rope(x, cos, sin):
    L = x.shape[1]
    shp = (1, L) + (1,) * (x.ndim - 3) + (HEAD_DIM // 2,)
    cs = cos.reshape(shp).astype(x.dtype)
    sn = sin.reshape(shp).astype(x.dtype)
    x1, x2 = jnp.split(x, 2, axis=-1)
    return jnp.concatenate([x1 * cs - x2 * sn, x1 * sn + x2 * cs], axis=-1)


def softmax_with_sink(s, sink):
    m = jnp.maximum(jnp.max(s, axis=-1, keepdims=True), sink)
    p = jnp.exp(s - m)
    return p / (jnp.sum(p, axis=-1, keepdims=True) + jnp.exp(sink - m))


def window_gqa(hx, hc, wq, wk, wv, wo, sink, cos, sin, need_ctx):
    B, L, _ = hx.shape
    C = hc.shape[1]
    G = A_HEADS // A_KV_HEADS
    nb = L // BLOCK
    scale = HEAD_DIM ** -0.5
    q = apply_rope((hx @ wq).reshape(B, L, A_KV_HEADS, G, HEAD_DIM), cos, sin)
    k = apply_rope((hx @ wk).reshape(B, L, A_KV_HEADS, HEAD_DIM), cos, sin)
    v = (hx @ wv).reshape(B, L, A_KV_HEADS, HEAD_DIM)
    kc = (hc @ wk).reshape(B, C, A_KV_HEADS, HEAD_DIM)
    vc = (hc @ wv).reshape(B, C, A_KV_HEADS, HEAD_DIM)
    sink_f = sink.astype(jnp.float32).reshape(A_KV_HEADS, G, 1, 1)
    pad = ((0, 0), (BLOCK, BLOCK), (0, 0), (0, 0))
    kp = jnp.pad(k, pad)
    vp = jnp.pad(v, pad)
    qb = jnp.moveaxis(q.reshape(B, nb, BLOCK, A_KV_HEADS, G, HEAD_DIM), 1, 0)
    qi = jnp.arange(BLOCK)[:, None]
    kj = jnp.arange(3 * BLOCK)[None, :]
    rel = qi + BLOCK - kj

    def block_fn(args):
        n, qblk = args
        kblk = lax.dynamic_slice_in_dim(kp, n * BLOCK, 3 * BLOCK, axis=1)
        vblk = lax.dynamic_slice_in_dim(vp, n * BLOCK, 3 * BLOCK, axis=1)
        kpos = n * BLOCK - BLOCK + kj
        valid = (jnp.abs(rel) <= WINDOW) & (kpos >= 0) & (kpos < L)
        s_lat = jnp.einsum('bqhgd,bkhd->bhgqk', qblk, kblk).astype(jnp.float32) * scale
        s_lat = jnp.where(valid, s_lat, NEG_INF)
        s_ctx = jnp.einsum('bqhgd,bchd->bhgqc', qblk, kc).astype(jnp.float32) * scale
        p = softmax_with_sink(jnp.concatenate([s_lat, s_ctx], axis=-1), sink_f).astype(v.dtype)
        o = jnp.einsum('bhgqk,bkhd->bqhgd', p[..., :3 * BLOCK], vblk)
        return o + jnp.einsum('bhgqc,bchd->bqhgd', p[..., 3 * BLOCK:], vc)

    ob = lax.map(block_fn, (jnp.arange(nb), qb))
    out_x = jnp.moveaxis(ob, 0, 1).reshape(B, L, A_HEADS * HEAD_DIM) @ wo
    out_c = None
    if need_ctx:
        qc = (hc @ wq).reshape(B, C, A_KV_HEADS, G, HEAD_DIM)
        s = jnp.einsum('bqhgd,bkhd->bhgqk', qc, kc).astype(jnp.float32) * scale
        p = softmax_with_sink(s, sink_f).astype(vc.dtype)
        out_c = jnp.einsum('bhgqk,bkhd->bqhgd', p, vc).reshape(B, C, A_HEADS * HEAD_DIM) @ wo
    return out_x, out_c


def diff_attention(hx, hc, wq, wk, wv, wo, lq1, lk1, lq2, lk2, subln_g, lam_init, cos, sin, need_ctx):
    B, L, _ = hx.shape
    C = hc.shape[1]
    H, d = B_HEADS, HEAD_DIM
    nb = L // BLOCK
    scale = d ** -0.5
    q = apply_rope((hx @ wq).reshape(B, L, H, 2, d), cos, sin)
    k = apply_rope((hx @ wk).reshape(B, L, H, 2, d), cos, sin)
    v = (hx @ wv).reshape(B, L, H, 2 * d)
    kc = (hc @ wk).reshape(B, C, H, 2, d)
    vc = (hc @ wv).reshape(B, C, H, 2 * d)
    lam = (jnp.exp(jnp.sum((lq1 * lk1).astype(jnp.float32)))
           - jnp.exp(jnp.sum((lq2 * lk2).astype(jnp.float32))) + lam_init)
    k_all = jnp.concatenate([k, kc], axis=1)
    v_all = jnp.concatenate([v, vc], axis=1)

    def diff_weights(qblk, keys):
        s = jnp.einsum('bqhtd,bkhtd->bhtqk', qblk, keys).astype(jnp.float32) * scale
        p = jax.nn.softmax(s, axis=-1)
        return p[:, :, 0] - lam * p[:, :, 1]

    def block_fn(qblk):
        a = diff_weights(qblk, k_all).astype(v.dtype)
        return jnp.einsum('bhqk,bkhe->bqhe', a, v_all)

    qb = jnp.moveaxis(q.reshape(B, nb, BLOCK, H, 2, d), 1, 0)
    ob = lax.map(block_fn, qb)
    ox = jnp.moveaxis(ob, 0, 1).reshape(B, L, H, 2 * d)

    def head_out(o):
        n = o.shape[1]
        o32 = o.astype(jnp.float32)
        o32 = o32 * lax.rsqrt(jnp.mean(jnp.square(o32), axis=-1, keepdims=True) + SUBLN_EPS)
        o32 = o32 * subln_g * (1.0 - lam_init)
        return o32.astype(o.dtype).reshape(B, n, H * 2 * d) @ wo

    out_x = head_out(ox)
    out_c = None
    if need_ctx:
        qc = (hc @ wq).reshape(B, C, H, 2, d)
        a = diff_weights(qc, kc).astype(vc.dtype)
        out_c = head_out(jnp.einsum('bhqk,bkhe->bqhe', a, vc))
    return out_x, out_c


def sqrelu_mlp(h, w1, w2):
    return jnp.square(jax.nn.relu(h @ w1)) @ w2


def setup_inputs(seed: int = 0) -> dict:
    key = jax.random.key(seed)
    ks = jax.random.split(key, 32)
    D = D_MODEL
    f32 = jnp.float32

    def nrm(k, shape, fan_in, gain=1.0):
        return jax.random.normal(k, shape, f32) * (gain * fan_in ** -0.5)

    def small(k, shape, s):
        return jax.random.normal(k, shape, f32) * s

    return {
        'x': jax.random.normal(ks[0], (BATCH, SEQ, D), f32),
        'c': jax.random.normal(ks[1], (BATCH, D), f32),
        'ctx': jax.random.normal(ks[2], (BATCH, CTX_LEN, D), f32),
        'c_ctx': jax.random.normal(ks[3], (D,), f32),
        'w_ada': nrm(ks[4], (DEPTH, D, N_MOD * D), D, 0.5),
        'b_ada': small(ks[5], (DEPTH, N_MOD * D), 0.02),
        'ln1_g': 1.0 + small(ks[6], (DEPTH, D), 0.05),
        'ln1_b': small(ks[7], (DEPTH, D), 0.02),
        'ln2_g': 1.0 + small(ks[8], (DEPTH, D), 0.05),
        'ln2_b': small(ks[9], (DEPTH, D), 0.02),
        'a_wq': nrm(ks[10], (N_A_LAYERS, D, A_HEADS * HEAD_DIM), D),
        'a_wk': nrm(ks[11], (N_A_LAYERS, D, A_KV_HEADS * HEAD_DIM), D),
        'a_wv': nrm(ks[12], (N_A_LAYERS, D, A_KV_HEADS * HEAD_DIM), D),
        'a_wo': nrm(ks[13], (N_A_LAYERS, A_HEADS * HEAD_DIM, D), A_HEADS * HEAD_DIM, DEEPNORM_BETA),
        'a_sink': small(ks[14], (N_A_LAYERS, A_HEADS), 1.0),
        'b_wq': nrm(ks[15], (N_B_LAYERS, D, B_HEADS * 2 * HEAD_DIM), D),
        'b_wk': nrm(ks[16], (N_B_LAYERS, D, B_HEADS * 2 * HEAD_DIM), D),
        'b_wv': nrm(ks[17], (N_B_LAYERS, D, B_HEADS * 2 * HEAD_DIM), D),
        'b_wo': nrm(ks[18], (N_B_LAYERS, B_HEADS * 2 * HEAD_DIM, D), B_HEADS * 2 * HEAD_DIM, DEEPNORM_BETA),
        'b_lq1': small(ks[19], (N_B_LAYERS, HEAD_DIM), 0.1),
        'b_lk1': small(ks[20], (N_B_LAYERS, HEAD_DIM), 0.1),
        'b_lq2': small(ks[21], (N_B_LAYERS, HEAD_DIM), 0.1),
        'b_lk2': small(ks[22], (N_B_LAYERS, HEAD_DIM), 0.1),
        'b_subln_g': 1.0 + small(ks[23], (N_B_LAYERS, 2 * HEAD_DIM), 0.05),
        'mlp_w1': nrm(ks[24], (DEPTH, D, D_FF), D),
        'mlp_w2': nrm(ks[25], (DEPTH, D_FF, D), D_FF, DEEPNORM_BETA),
    }


def reference(x, c, ctx, c_ctx, w_ada, b_ada, ln1_g, ln1_b, ln2_g, ln2_b,
              a_wq, a_wk, a_wv, a_wo, a_sink,
              b_wq, b_wk, b_wv, b_wo, b_lq1, b_lk1, b_lq2, b_lk2, b_subln_g,
              mlp_w1, mlp_w2):
    L = x.shape[1]
    cos, sin = axial_rope_tables(L)
    alpha = DEEPNORM_ALPHA
    for i in range(DEPTH):
        need_ctx = i < DEPTH - 1
        mod_x = jax.nn.silu(c) @ w_ada[i] + b_ada[i]
        mod_c = jax.nn.silu(c_ctx) @ w_ada[i] + b_ada[i]
        sh1, sc1, g1, sh2, sc2, g2 = jnp.split(mod_x[:, None, :], N_MOD, axis=-1)
        csh1, csc1, cg1, csh2, csc2, cg2 = jnp.split(mod_c, N_MOD, axis=-1)
        hx = x * (1.0 + sc1) + sh1
        hc = ctx * (1.0 + csc1) + csh1
        j = i // N_MIXERS
        if i % N_MIXERS == 0:
            ax, ac = window_gqa(hx, hc, a_wq[j], a_wk[j], a_wv[j], a_wo[j], a_sink[j], cos, sin, need_ctx)
        else:
            lam_init = 0.8 - 0.6 * math.exp(-0.3 * i)
            ax, ac = diff_attention(hx, hc, b_wq[j], b_wk[j], b_wv[j], b_wo[j],
                                    b_lq1[j], b_lk1[j], b_lq2[j], b_lk2[j], b_subln_g[j],
                                    lam_init, cos, sin, need_ctx)
        x = layer_norm(alpha * x + g1 * ax, ln1_g[i], ln1_b[i])
        fx = sqrelu_mlp(x * (1.0 + sc2) + sh2, mlp_w1[i], mlp_w2[i])
        x = layer_norm(alpha * x + g2 * fx, ln2_g[i], ln2_b[i])
        if need_ctx:
            ctx = layer_norm(alpha * ctx + cg1 * ac, ln1_g[i], ln1_b[i])
            fc = sqrelu_mlp(ctx * (1.0 + csc2) + csh2, mlp_w1[i], mlp_w2[i])
            ctx = layer_norm(alpha * ctx + cg2 * fc, ln2_g[i], ln2_b[i])
    return x
```

```cpp
#include <hip/hip_runtime.h>
#include <hip/hip_cooperative_groups.h>
#include <cstdio>
#include <cstdint>
namespace cg = cooperative_groups;

constexpr int NB = 16, SEQ = 2048, CTXL = 256, DM = 1024, FF = 4096;
constexpr int ML = NB * SEQ, MC = NB * CTXL, MT = ML + MC;
constexpr int NMODC = 6 * DM;
constexpr float LOG2E = 1.4426950408889634f;
constexpr float DN_ALPHA = 1.4142135623730951f;
constexpr float LAM_INIT = 0.35550906759096926f;

namespace pg8 {
#define PG8_LAS __attribute__((address_space(3)))
typedef unsigned short bf16_t;
typedef short bf16x8 __attribute__((ext_vector_type(8)));
typedef float f32x4 __attribute__((ext_vector_type(4)));
typedef unsigned u32x4 __attribute__((ext_vector_type(4)));
constexpr int BM = 256, BK = 64, HALF = 128, HTB = HALF * BK * 2  , STAGE_BYTES = 8 * HTB, NXCD = 8, WGM = 8;

__host__ __device__ __forceinline__ int lds_byte(int r, int c) { const int st = (r >> 4) * 2 + (c >> 5), rr = r & 15, cc = c & 31, ob = rr * 64 + cc * 2; return st * 1024 + (ob ^ (((ob >> 9) & 1) << 5)); }
__host__ __device__ __forceinline__ void stage_rc(int b, int& R, int& C) { const int st = b / 1024, sb = b % 1024, swz = sb ^ (((sb >> 9) & 1) << 5); R = (st >> 1) * 16 + swz / 64; C = (st & 1) * 32 + (swz % 64) / 2; }
__host__ __device__ __forceinline__ int perm32(int rho) { const int n = rho >> 4, i = rho & 15; return 8 * (i >> 2) + 4 * n + (i & 3); }

struct Unit { int pm, pn; };
struct Gemm { const bf16_t* A; const bf16_t* Bt; int M, N, K; };

struct StaticOrder {
    int nM, nN, nwg, G, c;
    __host__ __device__ void init(int M, int N, int G_, int c_) { nM = M / BM; nN = N / BM; nwg = nM * nN; G = G_; c = c_; }
    __host__ __device__ bool next(int i, Unit& u) const {
        const long L = (long)i * G + c; if (L >= nwg) return false;
        int wgid = (int)L; { const int q = nwg / NXCD, r = nwg % NXCD, xcd = wgid % NXCD, off = wgid / NXCD; wgid = (xcd < r ? xcd * (q + 1) : r * (q + 1) + (xcd - r) * q) + off; }
        const int nig = WGM * nN, gid = wgid / nig, fm = gid * WGM, gsz = (nM - fm) < WGM ? (nM - fm) : WGM;
        u.pm = fm + ((wgid % nig) % gsz); u.pn = (wgid % nig) / gsz; return true;
    }
    __device__ __forceinline__ void a_ready(const Unit&) const {}
    __device__ __forceinline__ void done(const Unit&) const {}
};

__device__ __forceinline__ unsigned cvt_pk_bf16(float lo, float hi) { unsigned r; asm volatile("v_cvt_pk_bf16_f32 %0, %1, %2" : "=v"(r) : "v"(lo), "v"(hi)); return r; }
typedef float f32x2 __attribute__((ext_vector_type(2)));
typedef unsigned u32x2 __attribute__((ext_vector_type(2)));
struct EpiQKV {
    static constexpr bool PERM = true, AFTER_DRAIN = false;
    bf16_t *Q, *Kb, *Vb; int KW; float qscale;
    __device__ __forceinline__ void operator()(const f32x4 (&acc)[2][2][4][2], const Unit& u, int wr, int wc, int fr, int fq) const {
        const int row0 = u.pm * BM + wr * 64 + fr;
        const bool latent = (u.pm * BM) < ML;
        float invf[4];
#pragma unroll
        for (int e = 0; e < 4; ++e) invf[e] = __builtin_amdgcn_exp2f(-(float)(4 * fq + e) * (13.287712379549449f / 16.0f));
#pragma unroll
        for (int bj = 0; bj < 2; ++bj) {
            const int ctile = u.pn * BM + bj * HALF;
            bf16_t* dst; int ld, cbase; bool rope; float sc;
            if (ctile < DM) { dst = Q; ld = DM; cbase = ctile; rope = true; sc = qscale; }
            else if (ctile < DM + KW) { dst = Kb; ld = KW; cbase = ctile - DM; rope = true; sc = 1.f; }
            else { dst = Vb; ld = KW; cbase = ctile - DM - KW; rope = false; sc = 1.f; }
            rope = rope && latent;
            const int col0 = cbase + wc * 32 + 8 * fq;
#pragma unroll
            for (int ai = 0; ai < 2; ++ai)
#pragma unroll
                for (int m = 0; m < 4; ++m) {
                    const int row = row0 + ai * HALF + m * 16;
                    f32x4 v0 = acc[ai][bj][m][0], v1 = acc[ai][bj][m][1];
                    if (rope) {
                        const int t = row & (SEQ - 1);
                        const float pos = (float)((wc & 1) ? (t & 63) : (t >> 6));
                        f32x4 o0, o1;
#pragma unroll
                        for (int e = 0; e < 4; ++e) { const float ang = pos * invf[e]; const float cs = __cosf(ang), sn = __sinf(ang);
                            o0[e] = v0[e] * cs - v1[e] * sn; o1[e] = v0[e] * sn + v1[e] * cs; }
                        v0 = o0; v1 = o1;
                    }
                    v0 = v0 * sc; v1 = v1 * sc;
                    u32x4 w; w.x = cvt_pk_bf16(v0[0], v0[1]); w.y = cvt_pk_bf16(v0[2], v0[3]); w.z = cvt_pk_bf16(v1[0], v1[1]); w.w = cvt_pk_bf16(v1[2], v1[3]);
                    *(u32x4*)(dst + (size_t)row * ld + col0) = w;
                }
        }
    }
};
struct EpiRelu2 {
    static constexpr bool PERM = true, AFTER_DRAIN = false;
    bf16_t* O; int ldc;
    __device__ __forceinline__ void operator()(const f32x4 (&acc)[2][2][4][2], const Unit& u, int wr, int wc, int fr, int fq) const {
        const int row0 = u.pm * BM + wr * 64 + fr, col0 = u.pn * BM + wc * 32 + 8 * fq;
#pragma unroll
        for (int ai = 0; ai < 2; ++ai)
#pragma unroll
            for (int m = 0; m < 4; ++m) { bf16_t* rowp = O + (size_t)(row0 + ai * HALF + m * 16) * ldc + col0;
#pragma unroll
                for (int bj = 0; bj < 2; ++bj) { f32x4 v0 = acc[ai][bj][m][0], v1 = acc[ai][bj][m][1];
#pragma unroll
                    for (int e = 0; e < 4; ++e) { const float a = fmaxf(v0[e], 0.f), b = fmaxf(v1[e], 0.f); v0[e] = a * a; v1[e] = b * b; }
                    u32x4 w; w.x = cvt_pk_bf16(v0[0], v0[1]); w.y = cvt_pk_bf16(v0[2], v0[3]); w.z = cvt_pk_bf16(v1[0], v1[1]); w.w = cvt_pk_bf16(v1[2], v1[3]);
                    *(u32x4*)(rowp + bj * HALF) = w; } }
    }
};
struct EpiResid {
    static constexpr bool PERM = false, AFTER_DRAIN = false;
    const float *xl, *xc; float *yl, *yc; const float* gate;
    __device__ __forceinline__ void operator()(const f32x4 (&acc)[2][2][4][2], const Unit& u, int wr, int wc, int fr, int fq) const {
        const int prow = u.pm * BM;
        const bool latent = prow < ML;
        const float* xin = latent ? xl + (size_t)prow * DM : xc + (size_t)(prow - ML) * DM;
        float* yout = latent ? yl + (size_t)prow * DM : yc + (size_t)(prow - ML) * DM;
        const float* gp = gate + (size_t)(latent ? (prow >> 11) : 16) * NMODC;
        const int col0 = u.pn * BM + wc * 32 + 4 * fq;
        f32x4 gv[2][2];
#pragma unroll
        for (int bj = 0; bj < 2; ++bj)
#pragma unroll
            for (int n = 0; n < 2; ++n) gv[bj][n] = *(const f32x4*)(gp + col0 + bj * HALF + n * 16);
#pragma unroll
        for (int ai = 0; ai < 2; ++ai)
#pragma unroll
            for (int m = 0; m < 4; ++m) { const size_t off = (size_t)(wr * 64 + fr + ai * HALF + m * 16) * DM + col0;
#pragma unroll
                for (int bj = 0; bj < 2; ++bj)
#pragma unroll
                    for (int n = 0; n < 2; ++n) { const f32x4 xv = *(const f32x4*)(xin + off + bj * HALF + n * 16);
                        *(f32x4*)(yout + off + bj * HALF + n * 16) = xv * DN_ALPHA + gv[bj][n] * acc[ai][bj][m][n]; } }
    }
};


template <class Epi, class Sched, bool ALIGN_EPI = false, bool SP2 = false>
__device__ __forceinline__ void gemm_phase(PG8_LAS unsigned char* lds, const Gemm g, const Sched& S, const Epi& E) {
    int tid_ = threadIdx.x; asm volatile("" : "+v"(tid_));
    const int tid = tid_, wid = __builtin_amdgcn_readfirstlane(tid >> 6), lane = tid & 63, wr = wid >> 2, wc = wid & 3, fr = lane & 15, fq = lane >> 4;
    const int K = g.K, nt = K / BK;
    unsigned voffA[2], voffB[2];
#pragma unroll
    for (int i = 0; i < 2; ++i) { int R, C; stage_rc(tid * 16 + i * 8192, R, C); const int Rb = Epi::PERM ? ((R & ~31) + perm32(R & 31)) : R;
        voffA[i] = (unsigned)(R * K + C) * 2u; voffB[i] = (unsigned)(Rb * K + C) * 2u; }
    const size_t kstep = (size_t)(BK * 2);
    const size_t hstep = (size_t)HALF * K * 2;
    const size_t tstep = 2 * hstep;
    const unsigned ldsw = (unsigned)wid * 1024u;
    const int aoff = lds_byte(wr * 64 + fr, fq * 8), boff = lds_byte(wc * 32 + fr, fq * 8);
#define PG8_SA(b, h) (((b) * 2 + (h)) * HTB)
#define PG8_SB(b, h) ((4 + (b) * 2 + (h)) * HTB)
#define PG8_STAGE(bufoff, gbase, voff) do { _Pragma("unroll") for (int _i = 0; _i < 2; ++_i) \
        __builtin_amdgcn_global_load_lds((const unsigned*)((const char*)(gbase) + (voff)[_i]), (PG8_LAS unsigned*)(lds + (bufoff) + ldsw + _i * 8192), 16, 0, 0); } while (0)
#define PG8_LDA(dst, b, h) do { _Pragma("unroll") for (int m = 0; m < 4; ++m) _Pragma("unroll") for (int k = 0; k < 2; ++k) dst[m][k] = *(const PG8_LAS bf16x8*)(lds + PG8_SA(b, h) + aoff + m * 2048 + k * 1024); } while (0)
#define PG8_LDB(dst, b, h) do { _Pragma("unroll") for (int n = 0; n < 2; ++n) _Pragma("unroll") for (int k = 0; k < 2; ++k) dst[n][k] = *(const PG8_LAS bf16x8*)(lds + PG8_SB(b, h) + boff + n * 2048 + k * 1024); } while (0)
#define PG8_MMA(ai, bj, At, Bt) do { __builtin_amdgcn_s_setprio(1); _Pragma("unroll") for (int m = 0; m < 4; ++m) _Pragma("unroll") for (int n = 0; n < 2; ++n) _Pragma("unroll") for (int k = 0; k < 2; ++k) \
        acc[ai][bj][m][n] = __builtin_amdgcn_mfma_f32_16x16x32_bf16(Bt[n][k], At[m][k], acc[ai][bj][m][n], 0, 0, 0); __builtin_amdgcn_s_setprio(0); } while (0)
#define PG8_WAIT_V(n) asm volatile("s_waitcnt vmcnt(" #n ")" ::: "memory")
#define PG8_WAIT_L(n) asm volatile("s_waitcnt lgkmcnt(" #n ")" ::: "memory")
#define PG8_BAR __builtin_amdgcn_s_barrier()
#define PG8_SCHED __builtin_amdgcn_sched_barrier(0)
    Unit cur, nxt; int ui = 0;
    if (!S.next(0, cur)) return;
    f32x4 acc[2][2][4][2];
#pragma unroll
    for (int a = 0; a < 2; ++a)
#pragma unroll
        for (int b = 0; b < 2; ++b)
#pragma unroll
            for (int m = 0; m < 4; ++m)
#pragma unroll
                for (int n = 0; n < 2; ++n) acc[a][b][m][n] = (f32x4){0.f, 0.f, 0.f, 0.f};
    bf16x8 At[4][2], B0[2][2], B1[2][2];
    const char* cA = (const char*)g.A + (size_t)cur.pm * tstep; const char* cB = (const char*)g.Bt + (size_t)cur.pn * tstep;
    S.a_ready(cur);
    if constexpr (SP2) {
        PG8_STAGE(PG8_SB(0, 0), cB, voffB); PG8_STAGE(PG8_SB(0, 1), cB + hstep, voffB); PG8_STAGE(PG8_SA(0, 0), cA, voffA); PG8_STAGE(PG8_SA(0, 1), cA + hstep, voffA);
        if (wr == 1) PG8_BAR;
        PG8_WAIT_V(2); PG8_BAR;
        PG8_STAGE(PG8_SB(1, 0), cB + kstep, voffB); PG8_STAGE(PG8_SA(1, 0), cA + kstep, voffA); PG8_STAGE(PG8_SB(1, 1), cB + hstep + kstep, voffB);
        PG8_WAIT_V(6); PG8_BAR;
    } else {
        PG8_STAGE(PG8_SB(0, 0), cB, voffB); PG8_STAGE(PG8_SA(0, 0), cA, voffA); PG8_STAGE(PG8_SB(0, 1), cB + hstep, voffB); PG8_STAGE(PG8_SA(0, 1), cA + hstep, voffA);
        if (wr == 1) PG8_BAR;
        PG8_WAIT_V(4); PG8_BAR;
        PG8_STAGE(PG8_SB(1, 0), cB + kstep, voffB); PG8_STAGE(PG8_SA(1, 0), cA + kstep, voffA); PG8_STAGE(PG8_SB(1, 1), cB + hstep + kstep, voffB);
        PG8_WAIT_V(6); PG8_BAR;
    }
    for (;;) {
        const bool has_next = S.next(ui + 1, nxt);
        const char* nA = has_next ? (const char*)g.A + (size_t)nxt.pm * tstep : cA; const char* nB = has_next ? (const char*)g.Bt + (size_t)nxt.pn * tstep : cB;
        for (int t = 0; t < nt; t += 2) {
            const bool last = (t == nt - 2);
            const char* a1 = cA + (size_t)(t + 1) * kstep;
            const char* a2 = last ? nA : cA + (size_t)(t + 2) * kstep; const char* b2 = last ? nB : cB + (size_t)(t + 2) * kstep;
            const char* a3 = a2 + kstep; const char* b3 = b2 + kstep;
            if (last && has_next) S.a_ready(nxt);
            if constexpr (SP2) {
            PG8_LDB(B0, 0, 0); PG8_LDB(B1, 0, 1); PG8_SCHED; PG8_LDA(At, 0, 0); PG8_STAGE(PG8_SA(1, 1), a1 + hstep, voffA);
            PG8_WAIT_V(8); PG8_WAIT_L(0); PG8_BAR; PG8_MMA(0, 0, At, B0); PG8_MMA(0, 1, At, B1); PG8_BAR; PG8_SCHED;
            PG8_LDA(At, 0, 1); PG8_STAGE(PG8_SB(0, 0), b2, voffB); PG8_STAGE(PG8_SB(0, 1), b2 + hstep, voffB); PG8_STAGE(PG8_SA(0, 0), a2, voffA);
            PG8_WAIT_V(8); PG8_WAIT_L(0); PG8_BAR; PG8_MMA(1, 0, At, B0); PG8_MMA(1, 1, At, B1); PG8_BAR; PG8_SCHED;
            PG8_LDB(B0, 1, 0); PG8_LDB(B1, 1, 1); PG8_SCHED; PG8_LDA(At, 1, 0); PG8_STAGE(PG8_SA(0, 1), a2 + hstep, voffA);
            PG8_WAIT_V(8); PG8_WAIT_L(0); PG8_BAR; PG8_MMA(0, 0, At, B0); PG8_MMA(0, 1, At, B1); PG8_BAR; PG8_SCHED;
            PG8_LDA(At, 1, 1); PG8_STAGE(PG8_SB(1, 0), b3, voffB); PG8_STAGE(PG8_SB(1, 1), b3 + hstep, voffB); PG8_STAGE(PG8_SA(1, 0), a3, voffA);
            PG8_WAIT_V(8); PG8_WAIT_L(0); PG8_BAR; PG8_MMA(1, 0, At, B0); PG8_MMA(1, 1, At, B1); PG8_BAR; PG8_SCHED;
            } else {
            PG8_LDB(B0, 0, 0); PG8_SCHED; PG8_LDA(At, 0, 0); PG8_STAGE(PG8_SA(1, 1), a1 + hstep, voffA);
            PG8_WAIT_L(8); PG8_BAR; PG8_WAIT_L(0); PG8_MMA(0, 0, At, B0); PG8_BAR; PG8_SCHED;
            PG8_LDB(B1, 0, 1); PG8_STAGE(PG8_SB(0, 0), b2, voffB);
            PG8_BAR; PG8_WAIT_L(0); PG8_MMA(0, 1, At, B1); PG8_BAR;
            PG8_LDA(At, 0, 1); PG8_STAGE(PG8_SA(0, 0), a2, voffA);
            PG8_BAR; PG8_WAIT_L(0); PG8_MMA(1, 0, At, B0); PG8_BAR; PG8_SCHED;
            PG8_STAGE(PG8_SB(0, 1), b2 + hstep, voffB);
            PG8_WAIT_V(6); PG8_BAR; PG8_MMA(1, 1, At, B1); PG8_BAR;
            PG8_LDB(B0, 1, 0); PG8_SCHED; PG8_LDA(At, 1, 0); PG8_STAGE(PG8_SA(0, 1), a2 + hstep, voffA);
            PG8_WAIT_L(8); PG8_BAR; PG8_WAIT_L(0); PG8_MMA(0, 0, At, B0); PG8_BAR; PG8_SCHED;
            PG8_LDB(B1, 1, 1); PG8_STAGE(PG8_SB(1, 0), b3, voffB);
            PG8_BAR; PG8_WAIT_L(0); PG8_MMA(0, 1, At, B1); PG8_BAR;
            PG8_LDA(At, 1, 1); PG8_STAGE(PG8_SA(1, 0), a3, voffA);
            PG8_BAR; PG8_WAIT_L(0); PG8_MMA(1, 0, At, B0); PG8_BAR; PG8_SCHED;
            PG8_STAGE(PG8_SB(1, 1), b3 + hstep, voffB);
            PG8_WAIT_V(6); PG8_BAR; PG8_MMA(1, 1, At, B1); PG8_BAR;
            }
        }
        if constexpr (ALIGN_EPI) { if (wr == 0) PG8_BAR; }
        if constexpr (!Epi::AFTER_DRAIN) { E(acc, cur, wr, wc, fr, fq); S.done(cur); }
        if (!has_next) break;
#pragma unroll
        for (int a = 0; a < 2; ++a)
#pragma unroll
            for (int b = 0; b < 2; ++b)
#pragma unroll
                for (int m = 0; m < 4; ++m)
#pragma unroll
                    for (int n = 0; n < 2; ++n) acc[a][b][m][n] = (f32x4){0.f, 0.f, 0.f, 0.f};
        cur = nxt; cA = nA; cB = nB; ++ui;
        if constexpr (ALIGN_EPI) { if (wr == 1) PG8_BAR; }
    }
    PG8_WAIT_V(0);
    if constexpr (!ALIGN_EPI) { if (wr == 0) PG8_BAR; }
    PG8_BAR;
    if constexpr (Epi::AFTER_DRAIN) { E.fused(acc, cur, wr, wc, fr, fq, lds, wid, lane); S.done(cur); }
#undef PG8_SA
#undef PG8_SB
#undef PG8_STAGE
#undef PG8_LDA
#undef PG8_LDB
#undef PG8_MMA
#undef PG8_WAIT_V
#undef PG8_WAIT_L
#undef PG8_BAR
#undef PG8_SCHED
}
}
#define LAS __attribute__((address_space(3)))
typedef unsigned short bf16_t;
typedef short bf16x8 __attribute__((ext_vector_type(8)));
typedef short s16x4 __attribute__((ext_vector_type(4)));
typedef float f32x4 __attribute__((ext_vector_type(4)));
typedef float f32x16 __attribute__((ext_vector_type(16)));
typedef unsigned u32x4 __attribute__((ext_vector_type(4)));
typedef unsigned u32x2 __attribute__((ext_vector_type(2)));
typedef float f32x2_t __attribute__((ext_vector_type(2)));
typedef __bf16 bf16x2_t __attribute__((ext_vector_type(2)));

constexpr size_t MiB = 1u << 20;
constexpr size_t WS_MISC = 0, WS_MOD = 1 * MiB;
constexpr size_t WS_WQKV0 = 2 * MiB, WS_WO0 = 5 * MiB, WS_W10 = 8 * MiB, WS_W20 = 16 * MiB;
constexpr size_t WS_WQKV1 = 24 * MiB, WS_WO1 = 30 * MiB, WS_W11 = 32 * MiB, WS_W21 = 40 * MiB;
constexpr size_t WS_XC = 48 * MiB;
constexpr size_t WS_HB = 64 * MiB;
constexpr size_t WS_Q = 136 * MiB, WS_K = 208 * MiB, WS_V = 280 * MiB, WS_AO = 352 * MiB;
constexpr size_t WS_HMID = 136 * MiB;
constexpr size_t WS_END = 424 * MiB;
constexpr int LDS_BYTES = 147456;

struct Params { const float* in[26]; float* out; unsigned char* ws; };

__device__ __forceinline__ unsigned pk2(float lo, float hi) { f32x2_t v = {lo, hi}; bf16x2_t b = __builtin_convertvector(v, bf16x2_t); return __builtin_bit_cast(unsigned, b); }
__device__ __forceinline__ float wave_sum(float v) {
#pragma unroll
    for (int o = 1; o < 64; o <<= 1) v += __shfl_xor(v, o);
    return v;
}
__device__ __forceinline__ float half_max(float m) { auto rr = __builtin_amdgcn_permlane32_swap(__float_as_uint(m), __float_as_uint(m), false, false); return fmaxf(__uint_as_float(rr[0]), __uint_as_float(rr[1])); }
__device__ __forceinline__ float half_sum(float m) { auto rr = __builtin_amdgcn_permlane32_swap(__float_as_uint(m), __float_as_uint(m), false, false); return __uint_as_float(rr[0]) + __uint_as_float(rr[1]); }
__device__ __forceinline__ s16x4 vtr(LAS const unsigned char* p) { typedef short v4i16_t __attribute__((ext_vector_type(4))); return __builtin_bit_cast(s16x4, __builtin_amdgcn_ds_read_tr16_b64_v4i16((LAS v4i16_t*)p)); }

__device__ __forceinline__ void phase_mods(const Params& P, LAS unsigned char* lds) {
    int tid_ = threadIdx.x; asm volatile("" : "+v"(tid_));
    const int tid = tid_, lane = tid & 63, wave = __builtin_amdgcn_readfirstlane(tid >> 6);
    float* mod = (float*)(P.ws + WS_MOD);
    if (blockIdx.x == gridDim.x - 1 && tid == 0) {
        float s1 = 0.f, s2 = 0.f;
        for (int i = 0; i < 64; ++i) { s1 += P.in[19][i] * P.in[20][i]; s2 += P.in[21][i] * P.in[22][i]; }
        ((float*)(P.ws + WS_MISC))[0] = __expf(s1) - __expf(s2) + LAM_INIT;
    }
    if (blockIdx.x >= 192) return;
    LAS float* S = (LAS float*)lds;
    LAS float* red = (LAS float*)(lds + 17 * 1024 * 4);
    for (int i = tid; i < 17 * 1024; i += 512) { const int r = i >> 10, k = i & 1023; const float v = r < 16 ? P.in[1][r * 1024 + k] : P.in[3][k]; S[i] = v / (1.f + __expf(-v)); }
    __syncthreads();
    for (int u = blockIdx.x; u < 192; u += gridDim.x) {
        const int l = u / 96, g = u % 96, n = g * 64 + lane;
        const float* W = P.in[4] + (size_t)l * DM * NMODC + n;
        float acc[17];
#pragma unroll
        for (int r = 0; r < 17; ++r) acc[r] = 0.f;
        const int k0 = wave * 128;
#pragma unroll 2
        for (int k = k0; k < k0 + 128; k += 4) {
            const float w0 = W[(size_t)k * NMODC], w1 = W[(size_t)(k + 1) * NMODC], w2 = W[(size_t)(k + 2) * NMODC], w3 = W[(size_t)(k + 3) * NMODC];
#pragma unroll
            for (int r = 0; r < 17; ++r) { const f32x4 s = *(const LAS f32x4*)(S + r * 1024 + k); acc[r] += (w0 * s.x + w1 * s.y) + (w2 * s.z + w3 * s.w); }
        }
#pragma unroll
        for (int r = 0; r < 17; ++r) red[(wave * 17 + r) * 64 + lane] = acc[r];
        __syncthreads();
        for (int idx = tid; idx < 17 * 64; idx += 512) { const int r = idx >> 6, ln = idx & 63; float s = 0.f;
#pragma unroll
            for (int w = 0; w < 8; ++w) s += red[(w * 17 + r) * 64 + ln];
            const int nn = g * 64 + ln; mod[(size_t)(l * 17 + r) * NMODC + nn] = s + P.in[5][l * NMODC + nn]; }
        __syncthreads();
    }
}
__device__ __forceinline__ unsigned f2bf(float f) { unsigned u = __builtin_bit_cast(unsigned, f); return (u + 0x7fffu + ((u >> 16) & 1u)) >> 16; }
__device__ __forceinline__ unsigned pk2i(float lo, float hi) { return f2bf(lo) | (f2bf(hi) << 16); }
__device__ __forceinline__ void transpose_item(const float* W, int K, int N, bf16_t* WT, int row_off, bool perm, LAS float* scr, int item, int lane) {
    const int nblk = N / 32, kb = item / nblk, nb = item % nblk, k0 = 64 * kb, n0 = 32 * nb;
    int sp = n0 + (lane & 31);
    if (perm) { const int p = sp & 63; sp = (sp & ~63) + 16 * (p >> 5) + 4 * ((p >> 3) & 3) + (p & 3) + 32 * ((p >> 2) & 1); }
#pragma unroll 8
    for (int i = 0; i < 32; ++i) { const int kk = 2 * i + (lane >> 5); scr[kk * 33 + (lane & 31)] = W[(size_t)(k0 + kk) * N + sp]; }
    asm volatile("s_waitcnt lgkmcnt(0)" ::: "memory");
    const int c = lane & 7;
#pragma unroll
    for (int j = 0; j < 4; ++j) { const int n = (lane >> 3) + 8 * j; const LAS float* s = scr + (8 * c) * 33 + n;
        u32x4 o; o.x = pk2i(s[0 * 33], s[1 * 33]); o.y = pk2i(s[2 * 33], s[3 * 33]); o.z = pk2i(s[4 * 33], s[5 * 33]); o.w = pk2i(s[6 * 33], s[7 * 33]);
        *(u32x4*)(WT + (size_t)(row_off + n0 + n) * K + k0 + 8 * c) = o; }
    asm volatile("s_waitcnt lgkmcnt(0)" ::: "memory");
}
__device__ __forceinline__ void phase_weights(const Params& P, LAS unsigned char* lds) {
    int tid_ = threadIdx.x; asm volatile("" : "+v"(tid_));
    const int lane = tid_ & 63, wave = __builtin_amdgcn_readfirstlane(tid_ >> 6);
    LAS float* scr = (LAS float*)(lds + wave * 16384);
    const int gw = blockIdx.x * 8 + wave, NGW = gridDim.x * 8;
    unsigned char* ws = P.ws;
    constexpr int I_DD = 16 * 32, I_DK0 = 16 * 4, I_1 = 16 * 128, I_2 = 64 * 32;
    constexpr int NITEMS = (I_DD + 2 * I_DK0 + I_DD + I_1 + I_2) + (4 * I_DD + I_1 + I_2);
    for (int it = gw; it < NITEMS; it += NGW) {
        int r = it;
#define TR_ITEM(cnt, W, K, N, WT, roff, perm) if (r < (cnt)) { transpose_item((W), (K), (N), (bf16_t*)(ws + (WT)), (roff), (perm), scr, r, lane); continue; } r -= (cnt);
        TR_ITEM(I_DD,  P.in[10], DM, DM,  WS_WQKV0, 0, true)
        TR_ITEM(I_DK0, P.in[11], DM, 128, WS_WQKV0, DM, true)
        TR_ITEM(I_DK0, P.in[12], DM, 128, WS_WQKV0, DM + 128, false)
        TR_ITEM(I_DD,  P.in[13], DM, DM,  WS_WO0, 0, false)
        TR_ITEM(I_1,   P.in[24], DM, FF,  WS_W10, 0, false)
        TR_ITEM(I_2,   P.in[25], FF, DM,  WS_W20, 0, false)
        TR_ITEM(I_DD,  P.in[15], DM, DM,  WS_WQKV1, 0, true)
        TR_ITEM(I_DD,  P.in[16], DM, DM,  WS_WQKV1, DM, true)
        TR_ITEM(I_DD,  P.in[17], DM, DM,  WS_WQKV1, 2 * DM, false)
        TR_ITEM(I_DD,  P.in[18], DM, DM,  WS_WO1, 0, false)
        TR_ITEM(I_1,   P.in[24] + (size_t)DM * FF, DM, FF, WS_W11, 0, false)
        TR_ITEM(I_2,   P.in[25] + (size_t)FF * DM, FF, DM, WS_W21, 0, false)
#undef TR_ITEM
    }
}
template <bool DO_LN>
__device__ __forceinline__ void row_phase(int nrows, const float* srcL, const float* srcC, float* dstL, float* dstC, const float* lng, const float* lnb,
                                          const float* modl  , int sh_chunk, int sc_chunk, bf16_t* HB) {
    int tid_ = threadIdx.x; asm volatile("" : "+v"(tid_));
    const int lane = tid_ & 63, wave = __builtin_amdgcn_readfirstlane(tid_ >> 6);
    const int gw = blockIdx.x * 8 + wave, NGW = gridDim.x * 8;
    for (int row = gw; row < nrows; row += NGW) {
        const bool latent = row < ML;
        const size_t roff = latent ? (size_t)row * DM : (size_t)(row - ML) * DM;
        const f32x4* xr = (const f32x4*)((latent ? srcL : srcC) + roff) + lane;
        f32x4 v[4];
#pragma unroll
        for (int j = 0; j < 4; ++j) v[j] = xr[64 * j];
        if (DO_LN) {
            float s = 0.f;
#pragma unroll
            for (int j = 0; j < 4; ++j) s += (v[j].x + v[j].y) + (v[j].z + v[j].w);
            const float mean = wave_sum(s) * (1.f / DM); float s2 = 0.f;
#pragma unroll
            for (int j = 0; j < 4; ++j) { v[j] = v[j] - mean; s2 += (v[j].x * v[j].x + v[j].y * v[j].y) + (v[j].z * v[j].z + v[j].w * v[j].w); }
            const float rstd = 1.f / sqrtf(wave_sum(s2) * (1.f / DM) + 1e-5f);
            f32x4* yr = (f32x4*)((latent ? dstL : dstC) + roff) + lane;
#pragma unroll
            for (int j = 0; j < 4; ++j) { const f32x4 g = ((const f32x4*)lng)[lane + 64 * j], b = ((const f32x4*)lnb)[lane + 64 * j]; v[j] = v[j] * rstd * g + b; yr[64 * j] = v[j]; }
        }
        if (HB) {
            const float* mrow = modl + (size_t)(latent ? (row >> 11) : 16) * NMODC;
            u32x2* hr = (u32x2*)(HB + (size_t)row * DM) + lane;
#pragma unroll
            for (int j = 0; j < 4; ++j) { const f32x4 sh = ((const f32x4*)(mrow + sh_chunk * DM))[lane + 64 * j], sc = ((const f32x4*)(mrow + sc_chunk * DM))[lane + 64 * j];
                const f32x4 h = v[j] * (sc + 1.0f) + sh; u32x2 w; w.x = pk2(h.x, h.y); w.y = pk2(h.z, h.w); hr[64 * j] = w; }
        }
    }
}
#define MFMA32(a, b, c) __builtin_amdgcn_mfma_f32_32x32x16_bf16((a), (b), (c), 0, 0, 0)
template <int ND>
__device__ __forceinline__ void softmax_tile(f32x16& p0, f32x16& p1, float& m, float& l, f32x16 (&o)[ND], bf16x8 (&pb)[2][2]) {
    float mx = fmaxf(p0[0], p1[0]);
#pragma unroll
    for (int i = 1; i < 16; ++i) mx = fmaxf(mx, fmaxf(p0[i], p1[i]));
    mx = half_max(mx);
    const float mnew = fmaxf(m, mx);
    const float alpha = __builtin_amdgcn_exp2f(m - mnew);
    m = mnew;
    float rs = 0.f;
#pragma unroll
    for (int i = 0; i < 16; ++i) { p0[i] = __builtin_amdgcn_exp2f(p0[i] - mnew); p1[i] = __builtin_amdgcn_exp2f(p1[i] - mnew); rs += p0[i] + p1[i]; }
    l = l * alpha + rs;
#pragma unroll
    for (int d = 0; d < ND; ++d) o[d] = o[d] * alpha;
#pragma unroll
    for (int s = 0; s < 2; ++s) {
        u32x4 w0, w1;
        w0.x = pk2(p0[8 * s + 0], p0[8 * s + 1]); w0.y = pk2(p0[8 * s + 2], p0[8 * s + 3]); w0.z = pk2(p0[8 * s + 4], p0[8 * s + 5]); w0.w = pk2(p0[8 * s + 6], p0[8 * s + 7]);
        w1.x = pk2(p1[8 * s + 0], p1[8 * s + 1]); w1.y = pk2(p1[8 * s + 2], p1[8 * s + 3]); w1.z = pk2(p1[8 * s + 4], p1[8 * s + 5]); w1.w = pk2(p1[8 * s + 6], p1[8 * s + 7]);
        pb[0][s] = __builtin_bit_cast(bf16x8, w0); pb[1][s] = __builtin_bit_cast(bf16x8, w1);
    }
}
template <int ND, int VS>
__device__ __forceinline__ void pv_tile(f32x16 (&o)[ND], const bf16x8 (&pb)[2][2], LAS const unsigned char* vb, int voff) {
#pragma unroll
    for (int kt = 0; kt < 2; ++kt)
#pragma unroll
        for (int s = 0; s < 2; ++s)
#pragma unroll
            for (int d0 = 0; d0 < ND; ++d0) {
                LAS const unsigned char* a = vb + voff + (kt * 32 + s * 16) * VS + d0 * 64;
                const s16x4 lo = vtr(a), hi4 = vtr(a + 8 * VS);
                const bf16x8 vf = {lo[0], lo[1], lo[2], lo[3], hi4[0], hi4[1], hi4[2], hi4[3]};
                o[d0] = MFMA32(vf, pb[kt][s], o[d0]);
            }
}

__device__ __forceinline__ void attn_window_phase(const Params& P, LAS unsigned char* lds) {
    constexpr int KS = 144, VS = 192, STAGE = 64 * KS + 64 * VS;
    int tid_ = threadIdx.x; asm volatile("" : "+v"(tid_));
    const int tid = tid_, lane = tid & 63, wave = __builtin_amdgcn_readfirstlane(tid >> 6), r = lane & 31, hi = lane >> 5;
    const bf16_t* Q = (const bf16_t*)(P.ws + WS_Q); const bf16_t* Kg = (const bf16_t*)(P.ws + WS_K); const bf16_t* Vg = (const bf16_t*)(P.ws + WS_V);
    bf16_t* AO = (bf16_t*)(P.ws + WS_AO);
    const int voff = (4 * hi + ((lane & 15) >> 2)) * VS + (16 * ((lane >> 4) & 1) + 4 * (lane & 3)) * 2;
    const int lkey = tid >> 3, lch = tid & 7;
    for (int u = blockIdx.x; u < 2304; u += gridDim.x) {
        int b, hk, sb; bool isctx;
        if (u < 2048) { const int c = u & 255, i = u >> 8; b = i * 2 + (c & 1); hk = (c >> 1) & 1; sb = c >> 2; isctx = false; }
        else { const int c = u - 2048; b = c & 15; hk = (c >> 4) & 1; sb = c >> 5; isctx = true; }
        const int q0 = sb * 32;
        const int qrow0 = isctx ? ML + b * CTXL + q0 : b * SEQ + q0;
        int klo = 0, nlat = 0;
        if (!isctx) { klo = (q0 - 128 > 0 ? q0 - 128 : 0) & ~63; int khi = (q0 + 160 + 63) & ~63; if (khi > SEQ) khi = SEQ; nlat = (khi - klo) >> 6; }
        const int nt = nlat + 4;
        const int h = hk * 8 + wave;
        bf16x8 qf[4];
        { const bf16_t* qp = Q + (size_t)(qrow0 + r) * DM + h * 64 + 8 * hi;
#pragma unroll
          for (int d0 = 0; d0 < 4; ++d0) qf[d0] = *(const bf16x8*)(qp + d0 * 16); }
        float m = P.in[14][h] * LOG2E, l = hi ? 0.f : 1.f;
        f32x16 o[2];
#pragma unroll
        for (int d = 0; d < 2; ++d)
#pragma unroll
            for (int i = 0; i < 16; ++i) o[d][i] = 0.f;
        u32x4 kreg, vreg;
#define TILE_ROW0(t) ((t) < nlat ? b * SEQ + klo + (t) * 64 : ML + b * CTXL + ((t) - nlat) * 64)
#define LOAD_TILE0(t) do { const size_t go = (size_t)(TILE_ROW0(t) + lkey) * 128 + hk * 64 + lch * 8; kreg = *(const u32x4*)(Kg + go); vreg = *(const u32x4*)(Vg + go); } while (0)
#define STORE_TILE0(st) do { *(LAS u32x4*)((st) + lkey * KS + lch * 16) = kreg; *(LAS u32x4*)((st) + 64 * KS + lkey * VS + lch * 16) = vreg; } while (0)
        LOAD_TILE0(0); STORE_TILE0(lds); __syncthreads();
        for (int t = 0; t < nt; ++t) {
            LAS unsigned char* st = lds + (t & 1) * STAGE;
            if (t + 1 < nt) LOAD_TILE0(t + 1);
            f32x16 p0, p1;
#pragma unroll
            for (int i = 0; i < 16; ++i) { p0[i] = 0.f; p1[i] = 0.f; }
#pragma unroll
            for (int d0 = 0; d0 < 4; ++d0) {
                const bf16x8 k0 = *(const LAS bf16x8*)(st + r * KS + d0 * 32 + hi * 16), k1 = *(const LAS bf16x8*)(st + (32 + r) * KS + d0 * 32 + hi * 16);
                p0 = MFMA32(k0, qf[d0], p0); p1 = MFMA32(k1, qf[d0], p1);
            }
            if (t < nlat) {
                const int dbase = klo + t * 64 + 4 * hi - (q0 + r);
#pragma unroll
                for (int i = 0; i < 16; ++i) { const int d = dbase + (i & 3) + 8 * (i >> 2);
                    if (d > 128 || d < -128) p0[i] = -1e30f;
                    if (d + 32 > 128 || d + 32 < -128) p1[i] = -1e30f; }
            }
            bf16x8 pb[2][2];
            softmax_tile<2>(p0, p1, m, l, o, pb);
            pv_tile<2, VS>(o, pb, st + 64 * KS, voff);
            if (t + 1 < nt) STORE_TILE0(lds + ((t + 1) & 1) * STAGE);
            __syncthreads();
        }
#undef TILE_ROW0
#undef LOAD_TILE0
#undef STORE_TILE0
        const float inv = 1.f / half_sum(l);
        bf16_t* op = AO + (size_t)(qrow0 + r) * DM + h * 64 + 4 * hi;
#pragma unroll
        for (int d0 = 0; d0 < 2; ++d0)
#pragma unroll
            for (int tq = 0; tq < 4; ++tq) { u32x2 w; w.x = pk2(o[d0][4 * tq] * inv, o[d0][4 * tq + 1] * inv); w.y = pk2(o[d0][4 * tq + 2] * inv, o[d0][4 * tq + 3] * inv);
                *(u32x2*)(op + d0 * 32 + 8 * tq) = w; }
    }
}

__device__ __forceinline__ void attn_diff_phase(const Params& P, LAS unsigned char* lds) {
    constexpr int KS = 272, VS = 320, STAGE = 64 * KS + 64 * VS;
    int tid_ = threadIdx.x; asm volatile("" : "+v"(tid_));
    const int tid = tid_, lane = tid & 63, wave = __builtin_amdgcn_readfirstlane(tid >> 6), r = lane & 31, hi = lane >> 5;
    const int tmap = wave >> 2, sq = wave & 3;
    const bf16_t* Q = (const bf16_t*)(P.ws + WS_Q); const bf16_t* Kg = (const bf16_t*)(P.ws + WS_K); const bf16_t* Vg = (const bf16_t*)(P.ws + WS_V);
    bf16_t* AO = (bf16_t*)(P.ws + WS_AO);
    const float lam = ((const float*)(P.ws + WS_MISC))[0];
    const float* subg = P.in[23];
    const int voff = (4 * hi + ((lane & 15) >> 2)) * VS + (16 * ((lane >> 4) & 1) + 4 * (lane & 3)) * 2;
    const int lkey = tid >> 4, lch = tid & 15;
    LAS float* xch = (LAS float*)lds;
    for (int u = blockIdx.x; u < 2048; u += gridDim.x) {
        const int c = u & 255, i = u >> 8; const int h = c & 7, qb = (c >> 3) & 15, b = i * 2 + (c >> 7);
        const int qrow0 = b * SEQ + qb * 128 + sq * 32;
        bf16x8 qf[4];
        { const bf16_t* qp = Q + (size_t)(qrow0 + r) * DM + (h * 2 + tmap) * 64 + 8 * hi;
#pragma unroll
          for (int d0 = 0; d0 < 4; ++d0) qf[d0] = *(const bf16x8*)(qp + d0 * 16); }
        float m = -1e30f, l = 0.f;
        f32x16 o[4];
#pragma unroll
        for (int d = 0; d < 4; ++d)
#pragma unroll
            for (int i2 = 0; i2 < 16; ++i2) o[d][i2] = 0.f;
        u32x4 kreg[2], vreg[2];
#define TILE_ROW1(t) ((t) < 32 ? b * SEQ + (t) * 64 : ML + b * CTXL + ((t) - 32) * 64)
#define LOAD_TILE1(t) do { const size_t go = (size_t)(TILE_ROW1(t) + lkey) * DM + h * 128 + lch * 8; kreg[0] = *(const u32x4*)(Kg + go); vreg[0] = *(const u32x4*)(Vg + go); \
                           kreg[1] = *(const u32x4*)(Kg + go + 32 * DM); vreg[1] = *(const u32x4*)(Vg + go + 32 * DM); } while (0)
#define STORE_TILE1(st) do { *(LAS u32x4*)((st) + lkey * KS + lch * 16) = kreg[0]; *(LAS u32x4*)((st) + (lkey + 32) * KS + lch * 16) = kreg[1]; \
                             *(LAS u32x4*)((st) + 64 * KS + lkey * VS + lch * 16) = vreg[0]; *(LAS u32x4*)((st) + 64 * KS + (lkey + 32) * VS + lch * 16) = vreg[1]; } while (0)
        LOAD_TILE1(0); STORE_TILE1(lds); __syncthreads();
        for (int t = 0; t < 36; ++t) {
            LAS unsigned char* st = lds + (t & 1) * STAGE;
            if (t + 1 < 36) LOAD_TILE1(t + 1);
            f32x16 p0, p1;
#pragma unroll
            for (int i2 = 0; i2 < 16; ++i2) { p0[i2] = 0.f; p1[i2] = 0.f; }
#pragma unroll
            for (int d0 = 0; d0 < 4; ++d0) {
                const bf16x8 k0 = *(const LAS bf16x8*)(st + r * KS + tmap * 128 + d0 * 32 + hi * 16), k1 = *(const LAS bf16x8*)(st + (32 + r) * KS + tmap * 128 + d0 * 32 + hi * 16);
                p0 = MFMA32(k0, qf[d0], p0); p1 = MFMA32(k1, qf[d0], p1);
            }
            bf16x8 pb[2][2];
            softmax_tile<4>(p0, p1, m, l, o, pb);
            pv_tile<4, VS>(o, pb, st + 64 * KS, voff);
            if (t + 1 < 36) STORE_TILE1(lds + ((t + 1) & 1) * STAGE);
            __syncthreads();
        }
#undef TILE_ROW1
#undef LOAD_TILE1
#undef STORE_TILE1
        const float inv = (tmap ? lam : 1.f) / half_sum(l);
        if (tmap == 1) {
#pragma unroll
            for (int d0 = 0; d0 < 4; ++d0)
#pragma unroll
                for (int i2 = 0; i2 < 16; ++i2) xch[(sq * 64 + d0 * 16 + i2) * 64 + lane] = o[d0][i2] * inv;
        }
        __syncthreads();
        if (tmap == 0) {
            float ss = 0.f;
#pragma unroll
            for (int d0 = 0; d0 < 4; ++d0)
#pragma unroll
                for (int i2 = 0; i2 < 16; ++i2) { const float v = o[d0][i2] * inv - xch[(sq * 64 + d0 * 16 + i2) * 64 + lane]; o[d0][i2] = v; ss += v * v; }
            ss = half_sum(ss);
            const float rs = (1.f - LAM_INIT) / sqrtf(ss * (1.f / 128.f) + 1e-5f);
            bf16_t* op = AO + (size_t)(qrow0 + r) * DM + h * 128 + 4 * hi;
#pragma unroll
            for (int d0 = 0; d0 < 4; ++d0)
#pragma unroll
                for (int tq = 0; tq < 4; ++tq) { const f32x4 g = *(const f32x4*)(subg + d0 * 32 + 8 * tq + 4 * hi);
                    u32x2 w; w.x = pk2(o[d0][4 * tq] * rs * g.x, o[d0][4 * tq + 1] * rs * g.y); w.y = pk2(o[d0][4 * tq + 2] * rs * g.z, o[d0][4 * tq + 3] * rs * g.w);
                    *(u32x2*)(op + d0 * 32 + 8 * tq) = w; }
        }
        __syncthreads();
    }
}
__global__ void __launch_bounds__(512) fwd_megakernel(Params P) {
    extern __shared__ __attribute__((aligned(16))) unsigned char lds_raw[];
    LAS unsigned char* lds = (LAS unsigned char*)lds_raw;
    cg::grid_group grid = cg::this_grid();
    unsigned char* ws = P.ws;
    float* mod = (float*)(ws + WS_MOD);
    float* XC = (float*)(ws + WS_XC);
    bf16_t* HB = (bf16_t*)(ws + WS_HB);
    bf16_t* Qb = (bf16_t*)(ws + WS_Q); bf16_t* Kb = (bf16_t*)(ws + WS_K); bf16_t* Vb = (bf16_t*)(ws + WS_V); bf16_t* AO = (bf16_t*)(ws + WS_AO);
    bf16_t* HM = (bf16_t*)(ws + WS_HMID);
    const int G = gridDim.x, bid = blockIdx.x;

    phase_mods(P, lds);
    __syncthreads();
    phase_weights(P, lds);
    grid.sync();
    row_phase<false>(MT, P.in[0], P.in[2], nullptr, nullptr, nullptr, nullptr, mod, 0, 1, HB);
    grid.sync();

    for (int layer = 0; layer < 2; ++layer) {
        const int Mrows = layer == 0 ? MT : ML;
        const float* modl = mod + (size_t)layer * 17 * NMODC;
        {
            const int KW = layer == 0 ? 128 : DM;
            pg8::Gemm g{HB, (const bf16_t*)(ws + (layer == 0 ? WS_WQKV0 : WS_WQKV1)), MT, DM + 2 * KW, DM};
            pg8::StaticOrder S; S.init(g.M, g.N, G, bid);
            pg8::EpiQKV E{Qb, Kb, Vb, KW, 0.125f * LOG2E};
            pg8::gemm_phase<pg8::EpiQKV, pg8::StaticOrder, true, true>(lds, g, S, E);
        }
        grid.sync();
        if (layer == 0) attn_window_phase(P, lds); else attn_diff_phase(P, lds);
        grid.sync();
        {
            pg8::Gemm g{AO, (const bf16_t*)(ws + (layer == 0 ? WS_WO0 : WS_WO1)), Mrows, DM, DM};
            pg8::StaticOrder S; S.init(g.M, g.N, G, bid);
            pg8::EpiResid E{layer == 0 ? P.in[0] : P.out, layer == 0 ? P.in[2] : XC, P.out, XC, modl + 2 * DM};
            pg8::gemm_phase<pg8::EpiResid, pg8::StaticOrder, true, true>(lds, g, S, E);
        }
        grid.sync();
        row_phase<true>(Mrows, P.out, XC, P.out, XC, P.in[6] + layer * DM, P.in[7] + layer * DM, modl, 3, 4, HB);
        grid.sync();
        {
            pg8::Gemm g{HB, (const bf16_t*)(ws + (layer == 0 ? WS_W10 : WS_W11)), Mrows, FF, DM};
            pg8::StaticOrder S; S.init(g.M, g.N, G, bid);
            pg8::EpiRelu2 E{HM, FF};
            pg8::gemm_phase<pg8::EpiRelu2, pg8::StaticOrder, true, true>(lds, g, S, E);
        }
        grid.sync();
        {
            pg8::Gemm g{HM, (const bf16_t*)(ws + (layer == 0 ? WS_W20 : WS_W21)), Mrows, DM, FF};
            pg8::StaticOrder S; S.init(g.M, g.N, G, bid);
            pg8::EpiResid E{P.out, XC, P.out, XC, modl + 5 * DM};
            pg8::gemm_phase<pg8::EpiResid, pg8::StaticOrder, true, true>(lds, g, S, E);
        }
        grid.sync();
        row_phase<true>(Mrows, P.out, XC, P.out, XC, P.in[8] + layer * DM, P.in[9] + layer * DM, modl + 17 * NMODC, 0, 1, layer == 0 ? HB : nullptr);
        if (layer == 0) grid.sync();
    }
}

extern "C" void kernel_launch(void* const* d_in, const int* in_sizes, int n_in, void* d_out, int out_size, void* d_ws, size_t ws_size, hipStream_t stream) {
    static int grid_blocks = 0;
    if (grid_blocks == 0) {
        if (n_in != 26 || out_size != ML * DM || ws_size < WS_END) { fprintf(stderr, "kernel_launch: unexpected shapes (n_in %d out %d ws %zu)\n", n_in, out_size, ws_size); grid_blocks = -1; return; }
        int dev = 0, cus = 0, per_cu = 0;
        hipGetDevice(&dev);
        hipDeviceGetAttribute(&cus, hipDeviceAttributeMultiprocessorCount, dev);
        hipFuncSetAttribute((const void*)fwd_megakernel, hipFuncAttributeMaxDynamicSharedMemorySize, LDS_BYTES);
        hipOccupancyMaxActiveBlocksPerMultiprocessor(&per_cu, (const void*)fwd_megakernel, 512, LDS_BYTES);
        if (per_cu < 1) { fprintf(stderr, "kernel_launch: occupancy query reports %d blocks per CU\n", per_cu); per_cu = 1; }
        grid_blocks = cus * per_cu;
        (void)hipGetLastError();
    }
    if (grid_blocks < 0) return;
    Params p{};
    for (int i = 0; i < 26; ++i) p.in[i] = (const float*)d_in[i];
    p.out = (float*)d_out; p.ws = (unsigned char*)d_ws;
    void* args[] = {&p};
    hipError_t e = hipLaunchCooperativeKernel((const void*)fwd_megakernel, dim3(grid_blocks), dim3(512), args, LDS_BYTES, stream);
    if (e != hipSuccess) fprintf(stderr, "cooperative launch failed: %s (grid %d)\n", hipGetErrorString(e), grid_blocks);
}
```

```cpp
#include <hip/hip_runtime.h>
#include <hip/hip_cooperative_groups.h>
#include <cstdio>
#include <cstdint>
namespace cg = cooperative_groups;

constexpr int NB = 16, SEQ = 2048, CTXL = 256, DM = 1024, FF = 4096;
constexpr int ML = NB * SEQ, MC = NB * CTXL, MT = ML + MC;
constexpr int NMODC = 6 * DM;
constexpr float LOG2E = 1.4426950408889634f;
constexpr float DN_ALPHA = 1.4142135623730951f;
constexpr float LAM_INIT = 0.35550906759096926f;

namespace pg8 {
#define PG8_LAS __attribute__((address_space(3)))
typedef unsigned short bf16_t;
typedef short bf16x8 __attribute__((ext_vector_type(8)));
typedef float f32x4 __attribute__((ext_vector_type(4)));
typedef unsigned u32x4 __attribute__((ext_vector_type(4)));
constexpr int BM = 256, BK = 64, HALF = 128, HTB = HALF * BK * 2  , STAGE_BYTES = 8 * HTB, NXCD = 8, WGM = 8;

__host__ __device__ __forceinline__ int lds_byte(int r, int c) { const int st = (r >> 4) * 2 + (c >> 5), rr = r & 15, cc = c & 31, ob = rr * 64 + cc * 2; return st * 1024 + (ob ^ (((ob >> 9) & 1) << 5)); }
__host__ __device__ __forceinline__ void stage_rc(int b, int& R, int& C) { const int st = b / 1024, sb = b % 1024, swz = sb ^ (((sb >> 9) & 1) << 5); R = (st >> 1) * 16 + swz / 64; C = (st & 1) * 32 + (swz % 64) / 2; }
__host__ __device__ __forceinline__ int perm32(int rho) { const int n = rho >> 4, i = rho & 15; return 8 * (i >> 2) + 4 * n + (i & 3); }

struct Unit { int pm, pn; };
struct Gemm { const bf16_t* A; const bf16_t* Bt; int M, N, K; };

struct StaticOrder {
    int nM, nN, nwg, G, c;
    __host__ __device__ void init(int M, int N, int G_, int c_) { nM = M / BM; nN = N / BM; nwg = nM * nN; G = G_; c = c_; }
    __host__ __device__ bool next(int i, Unit& u) const {
        const long L = (long)i * G + c; if (L >= nwg) return false;
        int wgid = (int)L; { const int q = nwg / NXCD, r = nwg % NXCD, xcd = wgid % NXCD, off = wgid / NXCD; wgid = (xcd < r ? xcd * (q + 1) : r * (q + 1) + (xcd - r) * q) + off; }
        const int nig = WGM * nN, gid = wgid / nig, fm = gid * WGM, gsz = (nM - fm) < WGM ? (nM - fm) : WGM;
        u.pm = fm + ((wgid % nig) % gsz); u.pn = (wgid % nig) / gsz; return true;
    }
    __device__ __forceinline__ void a_ready(const Unit&) const {}
    __device__ __forceinline__ void done(const Unit&) const {}
};

__device__ __forceinline__ unsigned cvt_pk_bf16(float lo, float hi) { unsigned r; asm volatile("v_cvt_pk_bf16_f32 %0, %1, %2" : "=v"(r) : "v"(lo), "v"(hi)); return r; }
typedef float f32x2 __attribute__((ext_vector_type(2)));
typedef unsigned u32x2 __attribute__((ext_vector_type(2)));
struct EpiQKV {
    static constexpr bool PERM = true, AFTER_DRAIN = false;
    bf16_t *Q, *Kb, *Vb; int KW; float qscale;
    __device__ __forceinline__ void operator()(const f32x4 (&acc)[2][2][4][2], const Unit& u, int wr, int wc, int fr, int fq) const {
        const int row0 = u.pm * BM + wr * 64 + fr;
        const bool latent = (u.pm * BM) < ML;
        float invf[4];
#pragma unroll
        for (int e = 0; e < 4; ++e) invf[e] = __builtin_amdgcn_exp2f(-(float)(4 * fq + e) * (13.287712379549449f / 16.0f));
#pragma unroll
        for (int bj = 0; bj < 2; ++bj) {
            const int ctile = u.pn * BM + bj * HALF;
            bf16_t* dst; int ld, cbase; bool rope; float sc;
            if (ctile < DM) { dst = Q; ld = DM; cbase = ctile; rope = true; sc = qscale; }
            else if (ctile < DM + KW) { dst = Kb; ld = KW; cbase = ctile - DM; rope = true; sc = 1.f; }
            else { dst = Vb; ld = KW; cbase = ctile - DM - KW; rope = false; sc = 1.f; }
            rope = rope && latent;
            const int col0 = cbase + wc * 32 + 8 * fq;
#pragma unroll
            for (int ai = 0; ai < 2; ++ai)
#pragma unroll
                for (int m = 0; m < 4; ++m) {
                    const int row = row0 + ai * HALF + m * 16;
                    f32x4 v0 = acc[ai][bj][m][0], v1 = acc[ai][bj][m][1];
                    if (rope) {
                        const int t = row & (SEQ - 1);
                        const float pos = (float)((wc & 1) ? (t & 63) : (t >> 6));
                        f32x4 o0, o1;
#pragma unroll
                        for (int e = 0; e < 4; ++e) { const float ang = pos * invf[e]; const float cs = __cosf(ang), sn = __sinf(ang);
                            o0[e] = v0[e] * cs - v1[e] * sn; o1[e] = v0[e] * sn + v1[e] * cs; }
                        v0 = o0; v1 = o1;
                    }
                    v0 = v0 * sc; v1 = v1 * sc;
                    u32x4 w; w.x = cvt_pk_bf16(v0[0], v0[1]); w.y = cvt_pk_bf16(v0[2], v0[3]); w.z = cvt_pk_bf16(v1[0], v1[1]); w.w = cvt_pk_bf16(v1[2], v1[3]);
                    *(u32x4*)(dst + (size_t)row * ld + col0) = w;
                }
        }
    }
};
struct EpiRelu2 {
    static constexpr bool PERM = true, AFTER_DRAIN = false;
    bf16_t* O; int ldc;
    __device__ __forceinline__ void operator()(const f32x4 (&acc)[2][2][4][2], const Unit& u, int wr, int wc, int fr, int fq) const {
        const int row0 = u.pm * BM + wr * 64 + fr, col0 = u.pn * BM + wc * 32 + 8 * fq;
#pragma unroll
        for (int ai = 0; ai < 2; ++ai)
#pragma unroll
            for (int m = 0; m < 4; ++m) { bf16_t* rowp = O + (size_t)(row0 + ai * HALF + m * 16) * ldc + col0;
#pragma unroll
                for (int bj = 0; bj < 2; ++bj) { f32x4 v0 = acc[ai][bj][m][0], v1 = acc[ai][bj][m][1];
#pragma unroll
                    for (int e = 0; e < 4; ++e) { const float a = fmaxf(v0[e], 0.f), b = fmaxf(v1[e], 0.f); v0[e] = a * a; v1[e] = b * b; }
                    u32x4 w; w.x = cvt_pk_bf16(v0[0], v0[1]); w.y = cvt_pk_bf16(v0[2], v0[3]); w.z = cvt_pk_bf16(v1[0], v1[1]); w.w = cvt_pk_bf16(v1[2], v1[3]);
                    *(u32x4*)(rowp + bj * HALF) = w; } }
    }
};
struct EpiResid {
    static constexpr bool PERM = false, AFTER_DRAIN = false;
    const float *xl, *xc; float *yl, *yc; const float* gate;
    __device__ __forceinline__ void operator()(const f32x4 (&acc)[2][2][4][2], const Unit& u, int wr, int wc, int fr, int fq) const {
        const int prow = u.pm * BM;
        const bool latent = prow < ML;
        const float* xin = latent ? xl + (size_t)prow * DM : xc + (size_t)(prow - ML) * DM;
        float* yout = latent ? yl + (size_t)prow * DM : yc + (size_t)(prow - ML) * DM;
        const float* gp = gate + (size_t)(latent ? (prow >> 11) : 16) * NMODC;
        const int col0 = u.pn * BM + wc * 32 + 4 * fq;
        f32x4 gv[2][2];
#pragma unroll
        for (int bj = 0; bj < 2; ++bj)
#pragma unroll
            for (int n = 0; n < 2; ++n) gv[bj][n] = *(const f32x4*)(gp + col0 + bj * HALF + n * 16);
#pragma unroll
        for (int ai = 0; ai < 2; ++ai)
#pragma unroll
            for (int m = 0; m < 4; ++m) { const size_t off = (size_t)(wr * 64 + fr + ai * HALF + m * 16) * DM + col0;
#pragma unroll
                for (int bj = 0; bj < 2; ++bj)
#pragma unroll
                    for (int n = 0; n < 2; ++n) { const f32x4 xv = *(const f32x4*)(xin + off + bj * HALF + n * 16);
                        *(f32x4*)(yout + off + bj * HALF + n * 16) = xv * DN_ALPHA + gv[bj][n] * acc[ai][bj][m][n]; } }
    }
};


template <class Epi, class Sched, bool ALIGN_EPI = false, bool SP2 = false>
__device__ __forceinline__ void gemm_phase(PG8_LAS unsigned char* lds, const Gemm g, const Sched& S, const Epi& E) {
    int tid_ = threadIdx.x; asm volatile("" : "+v"(tid_));
    const int tid = tid_, wid = __builtin_amdgcn_readfirstlane(tid >> 6), lane = tid & 63, wr = wid >> 2, wc = wid & 3, fr = lane & 15, fq = lane >> 4;
    const int K = g.K, nt = K / BK;
    unsigned voffA[2], voffB[2];
#pragma unroll
    for (int i = 0; i < 2; ++i) { int R, C; stage_rc(tid * 16 + i * 8192, R, C); const int Rb = Epi::PERM ? ((R & ~31) + perm32(R & 31)) : R;
        voffA[i] = (unsigned)(R * K + C) * 2u; voffB[i] = (unsigned)(Rb * K + C) * 2u; }
    const size_t kstep = (size_t)(BK * 2);
    const size_t hstep = (size_t)HALF * K * 2;
    const size_t tstep = 2 * hstep;
    const unsigned ldsw = (unsigned)wid * 1024u;
    const int aoff = lds_byte(wr * 64 + fr, fq * 8), boff = lds_byte(wc * 32 + fr, fq * 8);
#define PG8_SA(b, h) (((b) * 2 + (h)) * HTB)
#define PG8_SB(b, h) ((4 + (b) * 2 + (h)) * HTB)
#define PG8_STAGE(bufoff, gbase, voff) do { _Pragma("unroll") for (int _i = 0; _i < 2; ++_i) \
        __builtin_amdgcn_global_load_lds((const unsigned*)((const char*)(gbase) + (voff)[_i]), (PG8_LAS unsigned*)(lds + (bufoff) + ldsw + _i * 8192), 16, 0, 0); } while (0)
#define PG8_LDA(dst, b, h) do { _Pragma("unroll") for (int m = 0; m < 4; ++m) _Pragma("unroll") for (int k = 0; k < 2; ++k) dst[m][k] = *(const PG8_LAS bf16x8*)(lds + PG8_SA(b, h) + aoff + m * 2048 + k * 1024); } while (0)
#define PG8_LDB(dst, b, h) do { _Pragma("unroll") for (int n = 0; n < 2; ++n) _Pragma("unroll") for (int k = 0; k < 2; ++k) dst[n][k] = *(const PG8_LAS bf16x8*)(lds + PG8_SB(b, h) + boff + n * 2048 + k * 1024); } while (0)
#define PG8_MMA(ai, bj, At, Bt) do { __builtin_amdgcn_s_setprio(1); _Pragma("unroll") for (int m = 0; m < 4; ++m) _Pragma("unroll") for (int n = 0; n < 2; ++n) _Pragma("unroll") for (int k = 0; k < 2; ++k) \
        acc[ai][bj][m][n] = __builtin_amdgcn_mfma_f32_16x16x32_bf16(Bt[n][k], At[m][k], acc[ai][bj][m][n], 0, 0, 0); __builtin_amdgcn_s_setprio(0); } while (0)
#define PG8_WAIT_V(n) asm volatile("s_waitcnt vmcnt(" #n ")" ::: "memory")
#define PG8_WAIT_L(n) asm volatile("s_waitcnt lgkmcnt(" #n ")" ::: "memory")
#define PG8_BAR __builtin_amdgcn_s_barrier()
#define PG8_SCHED __builtin_amdgcn_sched_barrier(0)
    Unit cur, nxt; int ui = 0;
    if (!S.next(0, cur)) return;
    f32x4 acc[2][2][4][2];
#pragma unroll
    for (int a = 0; a < 2; ++a)
#pragma unroll
        for (int b = 0; b < 2; ++b)
#pragma unroll
            for (int m = 0; m < 4; ++m)
#pragma unroll
                for (int n = 0; n < 2; ++n) acc[a][b][m][n] = (f32x4){0.f, 0.f, 0.f, 0.f};
    bf16x8 At[4][2], B0[2][2], B1[2][2];
    const char* cA = (const char*)g.A + (size_t)cur.pm * tstep; const char* cB = (const char*)g.Bt + (size_t)cur.pn * tstep;
    S.a_ready(cur);
    if constexpr (SP2) {
        PG8_STAGE(PG8_SB(0, 0), cB, voffB); PG8_STAGE(PG8_SB(0, 1), cB + hstep, voffB); PG8_STAGE(PG8_SA(0, 0), cA, voffA); PG8_STAGE(PG8_SA(0, 1), cA + hstep, voffA);
        if (wr == 1) PG8_BAR;
        PG8_WAIT_V(2); PG8_BAR;
        PG8_STAGE(PG8_SB(1, 0), cB + kstep, voffB); PG8_STAGE(PG8_SA(1, 0), cA + kstep, voffA); PG8_STAGE(PG8_SB(1, 1), cB + hstep + kstep, voffB);
        PG8_WAIT_V(6); PG8_BAR;
    } else {
        PG8_STAGE(PG8_SB(0, 0), cB, voffB); PG8_STAGE(PG8_SA(0, 0), cA, voffA); PG8_STAGE(PG8_SB(0, 1), cB + hstep, voffB); PG8_STAGE(PG8_SA(0, 1), cA + hstep, voffA);
        if (wr == 1) PG8_BAR;
        PG8_WAIT_V(4); PG8_BAR;
        PG8_STAGE(PG8_SB(1, 0), cB + kstep, voffB); PG8_STAGE(PG8_SA(1, 0), cA + kstep, voffA); PG8_STAGE(PG8_SB(1, 1), cB + hstep + kstep, voffB);
        PG8_WAIT_V(6); PG8_BAR;
    }
    for (;;) {
        const bool has_next = S.next(ui + 1, nxt);
        const char* nA = has_next ? (const char*)g.A + (size_t)nxt.pm * tstep : cA; const char* nB = has_next ? (const char*)g.Bt + (size_t)nxt.pn * tstep : cB;
        for (int t = 0; t < nt; t += 2) {
            const bool last = (t == nt - 2);
            const char* a1 = cA + (size_t)(t + 1) * kstep;
            const char* a2 = last ? nA : cA + (size_t)(t + 2) * kstep; const char* b2 = last ? nB : cB + (size_t)(t + 2) * kstep;
            const char* a3 = a2 + kstep; const char* b3 = b2 + kstep;
            if (last && has_next) S.a_ready(nxt);
            if constexpr (SP2) {
            PG8_LDB(B0, 0, 0); PG8_LDB(B1, 0, 1); PG8_SCHED; PG8_LDA(At, 0, 0); PG8_STAGE(PG8_SA(1, 1), a1 + hstep, voffA);
            PG8_WAIT_V(8); PG8_WAIT_L(0); PG8_BAR; PG8_MMA(0, 0, At, B0); PG8_MMA(0, 1, At, B1); PG8_BAR; PG8_SCHED;
            PG8_LDA(At, 0, 1); PG8_STAGE(PG8_SB(0, 0), b2, voffB); PG8_STAGE(PG8_SB(0, 1), b2 + hstep, voffB); PG8_STAGE(PG8_SA(0, 0), a2, voffA);
            PG8_WAIT_V(8); PG8_WAIT_L(0); PG8_BAR; PG8_MMA(1, 0, At, B0); PG8_MMA(1, 1, At, B1); PG8_BAR; PG8_SCHED;
            PG8_LDB(B0, 1, 0); PG8_LDB(B1, 1, 1); PG8_SCHED; PG8_LDA(At, 1, 0); PG8_STAGE(PG8_SA(0, 1), a2 + hstep, voffA);
            PG8_WAIT_V(8); PG8_WAIT_L(0); PG8_BAR; PG8_MMA(0, 0, At, B0); PG8_MMA(0, 1, At, B1); PG8_BAR; PG8_SCHED;
            PG8_LDA(At, 1, 1); PG8_STAGE(PG8_SB(1, 0), b3, voffB); PG8_STAGE(PG8_SB(1, 1), b3 + hstep, voffB); PG8_STAGE(PG8_SA(1, 0), a3, voffA);
            PG8_WAIT_V(8); PG8_WAIT_L(0); PG8_BAR; PG8_MMA(1, 0, At, B0); PG8_MMA(1, 1, At, B1); PG8_BAR; PG8_SCHED;
            } else {
            PG8_LDB(B0, 0, 0); PG8_SCHED; PG8_LDA(At, 0, 0); PG8_STAGE(PG8_SA(1, 1), a1 + hstep, voffA);
            PG8_WAIT_L(8); PG8_BAR; PG8_WAIT_L(0); PG8_MMA(0, 0, At, B0); PG8_BAR; PG8_SCHED;
            PG8_LDB(B1, 0, 1); PG8_STAGE(PG8_SB(0, 0), b2, voffB);
            PG8_BAR; PG8_WAIT_L(0); PG8_MMA(0, 1, At, B1); PG8_BAR;
            PG8_LDA(At, 0, 1); PG8_STAGE(PG8_SA(0, 0), a2, voffA);
            PG8_BAR; PG8_WAIT_L(0); PG8_MMA(1, 0, At, B0); PG8_BAR; PG8_SCHED;
            PG8_STAGE(PG8_SB(0, 1), b2 + hstep, voffB);
            PG8_WAIT_V(6); PG8_BAR; PG8_MMA(1, 1, At, B1); PG8_BAR;
            PG8_LDB(B0, 1, 0); PG8_SCHED; PG8_LDA(At, 1, 0); PG8_STAGE(PG8_SA(0, 1), a2 + hstep, voffA);
            PG8_WAIT_L(8); PG8_BAR; PG8_WAIT_L(0); PG8_MMA(0, 0, At, B0); PG8_BAR; PG8_SCHED;
            PG8_LDB(B1, 1, 1); PG8_STAGE(PG8_SB(1, 0), b3, voffB);
            PG8_BAR; PG8_WAIT_L(0); PG8_MMA(0, 1, At, B1); PG8_BAR;
            PG8_LDA(At, 1, 1); PG8_STAGE(PG8_SA(1, 0), a3, voffA);
            PG8_BAR; PG8_WAIT_L(0); PG8_MMA(1, 0, At, B0); PG8_BAR; PG8_SCHED;
            PG8_STAGE(PG8_SB(1, 1), b3 + hstep, voffB);
            PG8_WAIT_V(6); PG8_BAR; PG8_MMA(1, 1, At, B1); PG8_BAR;
            }
        }
        if constexpr (ALIGN_EPI) { if (wr == 0) PG8_BAR; }
        if constexpr (!Epi::AFTER_DRAIN) { E(acc, cur, wr, wc, fr, fq); S.done(cur); }
        if (!has_next) break;
#pragma unroll
        for (int a = 0; a < 2; ++a)
#pragma unroll
            for (int b = 0; b < 2; ++b)
#pragma unroll
                for (int m = 0; m < 4; ++m)
#pragma unroll
                    for (int n = 0; n < 2; ++n) acc[a][b][m][n] = (f32x4){0.f, 0.f, 0.f, 0.f};
        cur = nxt; cA = nA; cB = nB; ++ui;
        if constexpr (ALIGN_EPI) { if (wr == 1) PG8_BAR; }
    }
    PG8_WAIT_V(0);
    if constexpr (!ALIGN_EPI) { if (wr == 0) PG8_BAR; }
    PG8_BAR;
    if constexpr (Epi::AFTER_DRAIN) { E.fused(acc, cur, wr, wc, fr, fq, lds, wid, lane); S.done(cur); }
#undef PG8_SA
#undef PG8_SB
#undef PG8_STAGE
#undef PG8_LDA
#undef PG8_LDB
#undef PG8_MMA
#undef PG8_WAIT_V
#undef PG8_WAIT_L
#undef PG8_BAR
#undef PG8_SCHED
}
}
#define LAS __attribute__((address_space(3)))
typedef unsigned short bf16_t;
typedef short bf16x8 __attribute__((ext_vector_type(8)));
typedef short s16x4 __attribute__((ext_vector_type(4)));
typedef float f32x4 __attribute__((ext_vector_type(4)));
typedef float f32x16 __attribute__((ext_vector_type(16)));
typedef unsigned u32x4 __attribute__((ext_vector_type(4)));
typedef unsigned u32x2 __attribute__((ext_vector_type(2)));
typedef float f32x2_t __attribute__((ext_vector_type(2)));
typedef __bf16 bf16x2_t __attribute__((ext_vector_type(2)));

constexpr size_t MiB = 1u << 20;
constexpr size_t WS_MISC = 0, WS_MOD = 1 * MiB;
constexpr size_t WS_WQKV0 = 2 * MiB, WS_WO0 = 5 * MiB, WS_W10 = 8 * MiB, WS_W20 = 16 * MiB;
constexpr size_t WS_WQKV1 = 24 * MiB, WS_WO1 = 30 * MiB, WS_W11 = 32 * MiB, WS_W21 = 40 * MiB;
constexpr size_t WS_XC = 48 * MiB;
constexpr size_t WS_HB = 64 * MiB;
constexpr size_t WS_Q = 136 * MiB, WS_K = 208 * MiB, WS_V = 280 * MiB, WS_AO = 352 * MiB;
constexpr size_t WS_HMID = 136 * MiB;
constexpr size_t WS_END = 424 * MiB;
constexpr int LDS_BYTES = 147456;

struct Params { const float* in[26]; float* out; unsigned char* ws; };
constexpr size_t WS_BAR = 65536;
constexpr int LDS_BARST = 131072 + 64;
#define XB_TMO      128
#define XB_XCNT(j)  (256  + 64 * (j))
#define XB_XSUB(j)  (1280 + 64 * (j))
#define XB_XGEN(j)  (2304 + 64 * (j))
#define XB_TOP      3328
#define XB_TOPGEN   3392
#define XCD_BAR_WORDS 3456
#define XB_SPIN_CAP (1u << 18)

__device__ __forceinline__ unsigned xb_ld(unsigned* p)              { return __hip_atomic_load(p, __ATOMIC_RELAXED, __HIP_MEMORY_SCOPE_AGENT); }
__device__ __forceinline__ unsigned xb_add(unsigned* p, unsigned v) { return __hip_atomic_fetch_add(p, v, __ATOMIC_RELAXED, __HIP_MEMORY_SCOPE_AGENT); }
__device__ __forceinline__ unsigned xb_xcc_id() { return (unsigned)__builtin_amdgcn_s_getreg((3 << 11) | 20) & 0xFu; }
#define XB_SPIN(cond, bar) do { unsigned _sp = 0; while (cond) { __builtin_amdgcn_s_sleep(1); \
    if ((++_sp & 255u) == 0u) { if (xb_ld(&(bar)[XB_TMO])) break; if (_sp > XB_SPIN_CAP) { atomicAdd(&(bar)[XB_TMO], 1u); break; } } } } while (0)

struct XcdBarrier {
    unsigned* bar; unsigned x;
    volatile LAS unsigned* st;
};

__device__ __forceinline__ XcdBarrier xcd_barrier_post(unsigned* bar, volatile LAS unsigned* st) {
    XcdBarrier b; b.bar = bar; b.x = xb_xcc_id(); b.st = st;
    if (threadIdx.x == 0) (void)xb_add(&bar[XB_XCNT(b.x)], 1u);
    return b;
}
__device__ __forceinline__ void xcd_barrier_complete(unsigned* bar, unsigned x, unsigned& nloc, unsigned& nx) {
    const unsigned G = gridDim.x * gridDim.y * gridDim.z;
    unsigned sum, cnt, mine, sp = 0u;
    for (;;) {
        sum = 0u; cnt = 0u; mine = 0u;
#pragma unroll
        for (unsigned j = 0; j < 16; ++j) { const unsigned c = xb_ld(&bar[XB_XCNT(j)]); sum += c; cnt += (c > 0u) ? 1u : 0u; mine = (j == x) ? c : mine; }
        if (sum == G) break;
        __builtin_amdgcn_s_sleep(1);
        if ((++sp & 255u) == 0u) { if (xb_ld(&bar[XB_TMO])) break; if (sp > XB_SPIN_CAP) { atomicAdd(&bar[XB_TMO], 1u); break; } }
    }
    nloc = mine > 0u ? mine : 1u; nx = cnt > 0u ? cnt : 1u;
}

__device__ __forceinline__ void xcd_barrier(const XcdBarrier& b) {
    asm volatile("s_waitcnt vmcnt(0)" ::: "memory");
    __syncthreads();
    if (threadIdx.x == 0) {
        unsigned* bar = b.bar;
        __builtin_amdgcn_s_waitcnt(0);
        unsigned nloc = b.st[0], nx = b.st[1];
        if (nloc == 0u) { xcd_barrier_complete(bar, b.x, nloc, nx); b.st[0] = nloc; b.st[1] = nx; }
        const unsigned old = xb_add(&bar[XB_XSUB(b.x)], 1u);
        const unsigned gen = old / nloc;
        if (old + 1u == (gen + 1u) * nloc) {
            __builtin_amdgcn_fence(__ATOMIC_RELEASE, "agent");
            asm volatile("s_waitcnt vmcnt(0)" ::: "memory");
            const unsigned og = xb_add(&bar[XB_TOP], 1u);
            const unsigned tg = og / nx;
            if (og + 1u == (tg + 1u) * nx) xb_add(&bar[XB_TOPGEN], 1u);
            else XB_SPIN(xb_ld(&bar[XB_TOPGEN]) == tg, bar);
            __builtin_amdgcn_fence(__ATOMIC_ACQUIRE, "agent");
            xb_add(&bar[XB_XGEN(b.x)], 1u);
            asm volatile("s_waitcnt vmcnt(0)" ::: "memory");
        } else {
            XB_SPIN(xb_ld(&bar[XB_XGEN(b.x)]) == gen, bar);
            __builtin_amdgcn_fence(__ATOMIC_ACQUIRE, "agent");
            asm volatile("s_waitcnt vmcnt(0)" ::: "memory");
        }
    }
    __syncthreads();
}


__device__ __forceinline__ unsigned pk2(float lo, float hi) { f32x2_t v = {lo, hi}; bf16x2_t b = __builtin_convertvector(v, bf16x2_t); return __builtin_bit_cast(unsigned, b); }
__device__ __forceinline__ float wave_sum(float v) {
#pragma unroll
    for (int o = 1; o < 64; o <<= 1) v += __shfl_xor(v, o);
    return v;
}
__device__ __forceinline__ float half_max(float m) { auto rr = __builtin_amdgcn_permlane32_swap(__float_as_uint(m), __float_as_uint(m), false, false); return fmaxf(__uint_as_float(rr[0]), __uint_as_float(rr[1])); }
__device__ __forceinline__ float half_sum(float m) { auto rr = __builtin_amdgcn_permlane32_swap(__float_as_uint(m), __float_as_uint(m), false, false); return __uint_as_float(rr[0]) + __uint_as_float(rr[1]); }
__device__ __forceinline__ s16x4 vtr(LAS const unsigned char* p) { typedef short v4i16_t __attribute__((ext_vector_type(4))); return __builtin_bit_cast(s16x4, __builtin_amdgcn_ds_read_tr16_b64_v4i16((LAS v4i16_t*)p)); }

__device__ __forceinline__ void phase_mods(const Params& P, LAS unsigned char* lds) {
    int tid_ = threadIdx.x; asm volatile("" : "+v"(tid_));
    const int tid = tid_, lane = tid & 63, wave = __builtin_amdgcn_readfirstlane(tid >> 6);
    float* mod = (float*)(P.ws + WS_MOD);
    if (blockIdx.x == gridDim.x - 1 && tid == 0) {
        float s1 = 0.f, s2 = 0.f;
        for (int i = 0; i < 64; ++i) { s1 += P.in[19][i] * P.in[20][i]; s2 += P.in[21][i] * P.in[22][i]; }
        ((float*)(P.ws + WS_MISC))[0] = __expf(s1) - __expf(s2) + LAM_INIT;
    }
    if (blockIdx.x >= 192) return;
    LAS float* S = (LAS float*)lds;
    LAS float* red = (LAS float*)(lds + 17 * 1024 * 4);
    for (int i = tid; i < 17 * 1024; i += 512) { const int r = i >> 10, k = i & 1023; const float v = r < 16 ? P.in[1][r * 1024 + k] : P.in[3][k]; S[i] = v / (1.f + __expf(-v)); }
    __syncthreads();
    for (int u = blockIdx.x; u < 192; u += gridDim.x) {
        const int l = u / 96, g = u % 96, n = g * 64 + lane;
        const float* W = P.in[4] + (size_t)l * DM * NMODC + n;
        float acc[17];
#pragma unroll
        for (int r = 0; r < 17; ++r) acc[r] = 0.f;
        const int k0 = wave * 128;
#pragma unroll 2
        for (int k = k0; k < k0 + 128; k += 4) {
            const float w0 = W[(size_t)k * NMODC], w1 = W[(size_t)(k + 1) * NMODC], w2 = W[(size_t)(k + 2) * NMODC], w3 = W[(size_t)(k + 3) * NMODC];
#pragma unroll
            for (int r = 0; r < 17; ++r) { const f32x4 s = *(const LAS f32x4*)(S + r * 1024 + k); acc[r] += (w0 * s.x + w1 * s.y) + (w2 * s.z + w3 * s.w); }
        }
#pragma unroll
        for (int r = 0; r < 17; ++r) red[(wave * 17 + r) * 64 + lane] = acc[r];
        __syncthreads();
        for (int idx = tid; idx < 17 * 64; idx += 512) { const int r = idx >> 6, ln = idx & 63; float s = 0.f;
#pragma unroll
            for (int w = 0; w < 8; ++w) s += red[(w * 17 + r) * 64 + ln];
            const int nn = g * 64 + ln; mod[(size_t)(l * 17 + r) * NMODC + nn] = s + P.in[5][l * NMODC + nn]; }
        __syncthreads();
    }
}
__device__ __forceinline__ unsigned f2bf(float f) { unsigned u = __builtin_bit_cast(unsigned, f); return (u + 0x7fffu + ((u >> 16) & 1u)) >> 16; }
__device__ __forceinline__ unsigned pk2i(float lo, float hi) { return f2bf(lo) | (f2bf(hi) << 16); }
__device__ __forceinline__ void transpose_item(const float* W, int K, int N, bf16_t* WT, int row_off, bool perm, LAS float* scr, int item, int lane) {
    const int nblk = N / 32, kb = item / nblk, nb = item % nblk, k0 = 64 * kb, n0 = 32 * nb;
    int sp = n0 + (lane & 31);
    if (perm) { const int p = sp & 63; sp = (sp & ~63) + 16 * (p >> 5) + 4 * ((p >> 3) & 3) + (p & 3) + 32 * ((p >> 2) & 1); }
#pragma unroll 8
    for (int i = 0; i < 32; ++i) { const int kk = 2 * i + (lane >> 5); scr[kk * 33 + (lane & 31)] = W[(size_t)(k0 + kk) * N + sp]; }
    asm volatile("s_waitcnt lgkmcnt(0)" ::: "memory");
    const int c = lane & 7;
#pragma unroll
    for (int j = 0; j < 4; ++j) { const int n = (lane >> 3) + 8 * j; const LAS float* s = scr + (8 * c) * 33 + n;
        u32x4 o; o.x = pk2i(s[0 * 33], s[1 * 33]); o.y = pk2i(s[2 * 33], s[3 * 33]); o.z = pk2i(s[4 * 33], s[5 * 33]); o.w = pk2i(s[6 * 33], s[7 * 33]);
        *(u32x4*)(WT + (size_t)(row_off + n0 + n) * K + k0 + 8 * c) = o; }
    asm volatile("s_waitcnt lgkmcnt(0)" ::: "memory");
}
__device__ __forceinline__ void phase_weights(const Params& P, LAS unsigned char* lds) {
    int tid_ = threadIdx.x; asm volatile("" : "+v"(tid_));
    const int lane = tid_ & 63, wave = __builtin_amdgcn_readfirstlane(tid_ >> 6);
    LAS float* scr = (LAS float*)(lds + wave * 16384);
    const int gw = blockIdx.x * 8 + wave, NGW = gridDim.x * 8;
    unsigned char* ws = P.ws;
    constexpr int I_DD = 16 * 32, I_DK0 = 16 * 4, I_1 = 16 * 128, I_2 = 64 * 32;
    constexpr int NITEMS = (I_DD + 2 * I_DK0 + I_DD + I_1 + I_2) + (4 * I_DD + I_1 + I_2);
    for (int it = gw; it < NITEMS; it += NGW) {
        int r = it;
#define TR_ITEM(cnt, W, K, N, WT, roff, perm) if (r < (cnt)) { transpose_item((W), (K), (N), (bf16_t*)(ws + (WT)), (roff), (perm), scr, r, lane); continue; } r -= (cnt);
        TR_ITEM(I_DD,  P.in[10], DM, DM,  WS_WQKV0, 0, true)
        TR_ITEM(I_DK0, P.in[11], DM, 128, WS_WQKV0, DM, true)
        TR_ITEM(I_DK0, P.in[12], DM, 128, WS_WQKV0, DM + 128, false)
        TR_ITEM(I_DD,  P.in[13], DM, DM,  WS_WO0, 0, false)
        TR_ITEM(I_1,   P.in[24], DM, FF,  WS_W10, 0, false)
        TR_ITEM(I_2,   P.in[25], FF, DM,  WS_W20, 0, false)
        TR_ITEM(I_DD,  P.in[15], DM, DM,  WS_WQKV1, 0, true)
        TR_ITEM(I_DD,  P.in[16], DM, DM,  WS_WQKV1, DM, true)
        TR_ITEM(I_DD,  P.in[17], DM, DM,  WS_WQKV1, 2 * DM, false)
        TR_ITEM(I_DD,  P.in[18], DM, DM,  WS_WO1, 0, false)
        TR_ITEM(I_1,   P.in[24] + (size_t)DM * FF, DM, FF, WS_W11, 0, false)
        TR_ITEM(I_2,   P.in[25] + (size_t)FF * DM, FF, DM, WS_W21, 0, false)
#undef TR_ITEM
    }
}
template <bool DO_LN>
__device__ __forceinline__ void row_phase(int nrows, const float* srcL, const float* srcC, float* dstL, float* dstC, const float* lng, const float* lnb,
                                          const float* modl  , int sh_chunk, int sc_chunk, bf16_t* HB) {
    int tid_ = threadIdx.x; asm volatile("" : "+v"(tid_));
    const int lane = tid_ & 63, wave = __builtin_amdgcn_readfirstlane(tid_ >> 6);
    const int gw = blockIdx.x * 8 + wave, NGW = gridDim.x * 8;
    for (int row = gw; row < nrows; row += NGW) {
        const bool latent = row < ML;
        const size_t roff = latent ? (size_t)row * DM : (size_t)(row - ML) * DM;
        const f32x4* xr = (const f32x4*)((latent ? srcL : srcC) + roff) + lane;
        f32x4 v[4];
#pragma unroll
        for (int j = 0; j < 4; ++j) v[j] = xr[64 * j];
        if (DO_LN) {
            float s = 0.f;
#pragma unroll
            for (int j = 0; j < 4; ++j) s += (v[j].x + v[j].y) + (v[j].z + v[j].w);
            const float mean = wave_sum(s) * (1.f / DM); float s2 = 0.f;
#pragma unroll
            for (int j = 0; j < 4; ++j) { v[j] = v[j] - mean; s2 += (v[j].x * v[j].x + v[j].y * v[j].y) + (v[j].z * v[j].z + v[j].w * v[j].w); }
            const float rstd = 1.f / sqrtf(wave_sum(s2) * (1.f / DM) + 1e-5f);
            f32x4* yr = (f32x4*)((latent ? dstL : dstC) + roff) + lane;
#pragma unroll
            for (int j = 0; j < 4; ++j) { const f32x4 g = ((const f32x4*)lng)[lane + 64 * j], b = ((const f32x4*)lnb)[lane + 64 * j]; v[j] = v[j] * rstd * g + b; yr[64 * j] = v[j]; }
        }
        if (HB) {
            const float* mrow = modl + (size_t)(latent ? (row >> 11) : 16) * NMODC;
            u32x2* hr = (u32x2*)(HB + (size_t)row * DM) + lane;
#pragma unroll
            for (int j = 0; j < 4; ++j) { const f32x4 sh = ((const f32x4*)(mrow + sh_chunk * DM))[lane + 64 * j], sc = ((const f32x4*)(mrow + sc_chunk * DM))[lane + 64 * j];
                const f32x4 h = v[j] * (sc + 1.0f) + sh; u32x2 w; w.x = pk2(h.x, h.y); w.y = pk2(h.z, h.w); hr[64 * j] = w; }
        }
    }
}
#define MFMA32(a, b, c) __builtin_amdgcn_mfma_f32_32x32x16_bf16((a), (b), (c), 0, 0, 0)
template <int ND>
__device__ __forceinline__ void softmax_tile(f32x16& p0, f32x16& p1, float& m, float& l, f32x16 (&o)[ND], bf16x8 (&pb)[2][2]) {
    float mx = fmaxf(p0[0], p1[0]);
#pragma unroll
    for (int i = 1; i < 16; ++i) mx = fmaxf(mx, fmaxf(p0[i], p1[i]));
    mx = half_max(mx);
    const float mnew = fmaxf(m, mx);
    const float alpha = __builtin_amdgcn_exp2f(m - mnew);
    m = mnew;
    float rs = 0.f;
#pragma unroll
    for (int i = 0; i < 16; ++i) { p0[i] = __builtin_amdgcn_exp2f(p0[i] - mnew); p1[i] = __builtin_amdgcn_exp2f(p1[i] - mnew); rs += p0[i] + p1[i]; }
    l = l * alpha + rs;
#pragma unroll
    for (int d = 0; d < ND; ++d) o[d] = o[d] * alpha;
#pragma unroll
    for (int s = 0; s < 2; ++s) {
        u32x4 w0, w1;
        w0.x = pk2(p0[8 * s + 0], p0[8 * s + 1]); w0.y = pk2(p0[8 * s + 2], p0[8 * s + 3]); w0.z = pk2(p0[8 * s + 4], p0[8 * s + 5]); w0.w = pk2(p0[8 * s + 6], p0[8 * s + 7]);
        w1.x = pk2(p1[8 * s + 0], p1[8 * s + 1]); w1.y = pk2(p1[8 * s + 2], p1[8 * s + 3]); w1.z = pk2(p1[8 * s + 4], p1[8 * s + 5]); w1.w = pk2(p1[8 * s + 6], p1[8 * s + 7]);
        pb[0][s] = __builtin_bit_cast(bf16x8, w0); pb[1][s] = __builtin_bit_cast(bf16x8, w1);
    }
}
template <int ND, int VS>
__device__ __forceinline__ void pv_tile(f32x16 (&o)[ND], const bf16x8 (&pb)[2][2], LAS const unsigned char* vb, int voff) {
#pragma unroll
    for (int kt = 0; kt < 2; ++kt)
#pragma unroll
        for (int s = 0; s < 2; ++s)
#pragma unroll
            for (int d0 = 0; d0 < ND; ++d0) {
                LAS const unsigned char* a = vb + voff + (kt * 32 + s * 16) * VS + d0 * 64;
                const s16x4 lo = vtr(a), hi4 = vtr(a + 8 * VS);
                const bf16x8 vf = {lo[0], lo[1], lo[2], lo[3], hi4[0], hi4[1], hi4[2], hi4[3]};
                o[d0] = MFMA32(vf, pb[kt][s], o[d0]);
            }
}

__device__ __forceinline__ void attn_window_phase(const Params& P, LAS unsigned char* lds) {
    constexpr int KS = 144, VS = 192, STAGE = 64 * KS + 64 * VS;
    int tid_ = threadIdx.x; asm volatile("" : "+v"(tid_));
    const int tid = tid_, lane = tid & 63, wave = __builtin_amdgcn_readfirstlane(tid >> 6), r = lane & 31, hi = lane >> 5;
    const bf16_t* Q = (const bf16_t*)(P.ws + WS_Q); const bf16_t* Kg = (const bf16_t*)(P.ws + WS_K); const bf16_t* Vg = (const bf16_t*)(P.ws + WS_V);
    bf16_t* AO = (bf16_t*)(P.ws + WS_AO);
    const int voff = (4 * hi + ((lane & 15) >> 2)) * VS + (16 * ((lane >> 4) & 1) + 4 * (lane & 3)) * 2;
    const int lkey = tid >> 3, lch = tid & 7;
    for (int u = blockIdx.x; u < 2304; u += gridDim.x) {
        int b, hk, sb; bool isctx;
        if (u < 2048) { const int c = u & 255, i = u >> 8; b = i * 2 + (c & 1); hk = (c >> 1) & 1; sb = c >> 2; isctx = false; }
        else { const int c = u - 2048; b = c & 15; hk = (c >> 4) & 1; sb = c >> 5; isctx = true; }
        const int q0 = sb * 32;
        const int qrow0 = isctx ? ML + b * CTXL + q0 : b * SEQ + q0;
        int klo = 0, nlat = 0;
        if (!isctx) { klo = (q0 - 128 > 0 ? q0 - 128 : 0) & ~63; int khi = (q0 + 160 + 63) & ~63; if (khi > SEQ) khi = SEQ; nlat = (khi - klo) >> 6; }
        const int nt = nlat + 4;
        const int h = hk * 8 + wave;
        bf16x8 qf[4];
        { const bf16_t* qp = Q + (size_t)(qrow0 + r) * DM + h * 64 + 8 * hi;
#pragma unroll
          for (int d0 = 0; d0 < 4; ++d0) qf[d0] = *(const bf16x8*)(qp + d0 * 16); }
        float m = P.in[14][h] * LOG2E, l = hi ? 0.f : 1.f;
        f32x16 o[2];
#pragma unroll
        for (int d = 0; d < 2; ++d)
#pragma unroll
            for (int i = 0; i < 16; ++i) o[d][i] = 0.f;
        u32x4 kreg, vreg;
#define TILE_ROW0(t) ((t) < nlat ? b * SEQ + klo + (t) * 64 : ML + b * CTXL + ((t) - nlat) * 64)
#define LOAD_TILE0(t) do { const size_t go = (size_t)(TILE_ROW0(t) + lkey) * 128 + hk * 64 + lch * 8; kreg = *(const u32x4*)(Kg + go); vreg = *(const u32x4*)(Vg + go); } while (0)
#define STORE_TILE0(st) do { *(LAS u32x4*)((st) + lkey * KS + lch * 16) = kreg; *(LAS u32x4*)((st) + 64 * KS + lkey * VS + lch * 16) = vreg; } while (0)
        LOAD_TILE0(0); STORE_TILE0(lds); __syncthreads();
        for (int t = 0; t < nt; ++t) {
            LAS unsigned char* st = lds + (t & 1) * STAGE;
            if (t + 1 < nt) LOAD_TILE0(t + 1);
            f32x16 p0, p1;
#pragma unroll
            for (int i = 0; i < 16; ++i) { p0[i] = 0.f; p1[i] = 0.f; }
#pragma unroll
            for (int d0 = 0; d0 < 4; ++d0) {
                const bf16x8 k0 = *(const LAS bf16x8*)(st + r * KS + d0 * 32 + hi * 16), k1 = *(const LAS bf16x8*)(st + (32 + r) * KS + d0 * 32 + hi * 16);
                p0 = MFMA32(k0, qf[d0], p0); p1 = MFMA32(k1, qf[d0], p1);
            }
            if (t < nlat) {
                const int dbase = klo + t * 64 + 4 * hi - (q0 + r);
#pragma unroll
                for (int i = 0; i < 16; ++i) { const int d = dbase + (i & 3) + 8 * (i >> 2);
                    if (d > 128 || d < -128) p0[i] = -1e30f;
                    if (d + 32 > 128 || d + 32 < -128) p1[i] = -1e30f; }
            }
            bf16x8 pb[2][2];
            softmax_tile<2>(p0, p1, m, l, o, pb);
            pv_tile<2, VS>(o, pb, st + 64 * KS, voff);
            if (t + 1 < nt) STORE_TILE0(lds + ((t + 1) & 1) * STAGE);
            __syncthreads();
        }
#undef TILE_ROW0
#undef LOAD_TILE0
#undef STORE_TILE0
        const float inv = 1.f / half_sum(l);
        bf16_t* op = AO + (size_t)(qrow0 + r) * DM + h * 64 + 4 * hi;
#pragma unroll
        for (int d0 = 0; d0 < 2; ++d0)
#pragma unroll
            for (int tq = 0; tq < 4; ++tq) { u32x2 w; w.x = pk2(o[d0][4 * tq] * inv, o[d0][4 * tq + 1] * inv); w.y = pk2(o[d0][4 * tq + 2] * inv, o[d0][4 * tq + 3] * inv);
                *(u32x2*)(op + d0 * 32 + 8 * tq) = w; }
    }
}

__device__ __forceinline__ void attn_diff_phase(const Params& P, LAS unsigned char* lds) {
    constexpr int KS = 272, VS = 320, STAGE = 64 * KS + 64 * VS;
    int tid_ = threadIdx.x; asm volatile("" : "+v"(tid_));
    const int tid = tid_, lane = tid & 63, wave = __builtin_amdgcn_readfirstlane(tid >> 6), r = lane & 31, hi = lane >> 5;
    const int tmap = wave >> 2, sq = wave & 3;
    const bf16_t* Q = (const bf16_t*)(P.ws + WS_Q); const bf16_t* Kg = (const bf16_t*)(P.ws + WS_K); const bf16_t* Vg = (const bf16_t*)(P.ws + WS_V);
    bf16_t* AO = (bf16_t*)(P.ws + WS_AO);
    const float lam = ((const float*)(P.ws + WS_MISC))[0];
    const float* subg = P.in[23];
    const int voff = (4 * hi + ((lane & 15) >> 2)) * VS + (16 * ((lane >> 4) & 1) + 4 * (lane & 3)) * 2;
    const int lkey = tid >> 4, lch = tid & 15;
    LAS float* xch = (LAS float*)lds;
    for (int u = blockIdx.x; u < 2048; u += gridDim.x) {
        const int c = u & 255, i = u >> 8; const int h = c & 7, qb = (c >> 3) & 15, b = i * 2 + (c >> 7);
        const int qrow0 = b * SEQ + qb * 128 + sq * 32;
        bf16x8 qf[4];
        { const bf16_t* qp = Q + (size_t)(qrow0 + r) * DM + (h * 2 + tmap) * 64 + 8 * hi;
#pragma unroll
          for (int d0 = 0; d0 < 4; ++d0) qf[d0] = *(const bf16x8*)(qp + d0 * 16); }
        float m = -1e30f, l = 0.f;
        f32x16 o[4];
#pragma unroll
        for (int d = 0; d < 4; ++d)
#pragma unroll
            for (int i2 = 0; i2 < 16; ++i2) o[d][i2] = 0.f;
        u32x4 kreg[2], vreg[2];
#define TILE_ROW1(t) ((t) < 32 ? b * SEQ + (t) * 64 : ML + b * CTXL + ((t) - 32) * 64)
#define LOAD_TILE1(t) do { const size_t go = (size_t)(TILE_ROW1(t) + lkey) * DM + h * 128 + lch * 8; kreg[0] = *(const u32x4*)(Kg + go); vreg[0] = *(const u32x4*)(Vg + go); \
                           kreg[1] = *(const u32x4*)(Kg + go + 32 * DM); vreg[1] = *(const u32x4*)(Vg + go + 32 * DM); } while (0)
#define STORE_TILE1(st) do { *(LAS u32x4*)((st) + lkey * KS + lch * 16) = kreg[0]; *(LAS u32x4*)((st) + (lkey + 32) * KS + lch * 16) = kreg[1]; \
                             *(LAS u32x4*)((st) + 64 * KS + lkey * VS + lch * 16) = vreg[0]; *(LAS u32x4*)((st) + 64 * KS + (lkey + 32) * VS + lch * 16) = vreg[1]; } while (0)
        LOAD_TILE1(0); STORE_TILE1(lds); __syncthreads();
        for (int t = 0; t < 36; ++t) {
            LAS unsigned char* st = lds + (t & 1) * STAGE;
            if (t + 1 < 36) LOAD_TILE1(t + 1);
            f32x16 p0, p1;
#pragma unroll
            for (int i2 = 0; i2 < 16; ++i2) { p0[i2] = 0.f; p1[i2] = 0.f; }
#pragma unroll
            for (int d0 = 0; d0 < 4; ++d0) {
                const bf16x8 k0 = *(const LAS bf16x8*)(st + r * KS + tmap * 128 + d0 * 32 + hi * 16), k1 = *(const LAS bf16x8*)(st + (32 + r) * KS + tmap * 128 + d0 * 32 + hi * 16);
                p0 = MFMA32(k0, qf[d0], p0); p1 = MFMA32(k1, qf[d0], p1);
            }
            bf16x8 pb[2][2];
            softmax_tile<4>(p0, p1, m, l, o, pb);
            pv_tile<4, VS>(o, pb, st + 64 * KS, voff);
            if (t + 1 < 36) STORE_TILE1(lds + ((t + 1) & 1) * STAGE);
            __syncthreads();
        }
#undef TILE_ROW1
#undef LOAD_TILE1
#undef STORE_TILE1
        const float inv = (tmap ? lam : 1.f) / half_sum(l);
        if (tmap == 1) {
#pragma unroll
            for (int d0 = 0; d0 < 4; ++d0)
#pragma unroll
                for (int i2 = 0; i2 < 16; ++i2) xch[(sq * 64 + d0 * 16 + i2) * 64 + lane] = o[d0][i2] * inv;
        }
        __syncthreads();
        if (tmap == 0) {
            float ss = 0.f;
#pragma unroll
            for (int d0 = 0; d0 < 4; ++d0)
#pragma unroll
                for (int i2 = 0; i2 < 16; ++i2) { const float v = o[d0][i2] * inv - xch[(sq * 64 + d0 * 16 + i2) * 64 + lane]; o[d0][i2] = v; ss += v * v; }
            ss = half_sum(ss);
            const float rs = (1.f - LAM_INIT) / sqrtf(ss * (1.f / 128.f) + 1e-5f);
            bf16_t* op = AO + (size_t)(qrow0 + r) * DM + h * 128 + 4 * hi;
#pragma unroll
            for (int d0 = 0; d0 < 4; ++d0)
#pragma unroll
                for (int tq = 0; tq < 4; ++tq) { const f32x4 g = *(const f32x4*)(subg + d0 * 32 + 8 * tq + 4 * hi);
                    u32x2 w; w.x = pk2(o[d0][4 * tq] * rs * g.x, o[d0][4 * tq + 1] * rs * g.y); w.y = pk2(o[d0][4 * tq + 2] * rs * g.z, o[d0][4 * tq + 3] * rs * g.w);
                    *(u32x2*)(op + d0 * 32 + 8 * tq) = w; }
        }
        __syncthreads();
    }
}
__global__ void __launch_bounds__(512) fwd_megakernel(Params P) {
    extern __shared__ __attribute__((aligned(16))) unsigned char lds_raw[];
    LAS unsigned char* lds = (LAS unsigned char*)lds_raw;
    cg::grid_group grid = cg::this_grid();
    unsigned char* ws = P.ws;
    float* mod = (float*)(ws + WS_MOD);
    float* XC = (float*)(ws + WS_XC);
    bf16_t* HB = (bf16_t*)(ws + WS_HB);
    bf16_t* Qb = (bf16_t*)(ws + WS_Q); bf16_t* Kb = (bf16_t*)(ws + WS_K); bf16_t* Vb = (bf16_t*)(ws + WS_V); bf16_t* AO = (bf16_t*)(ws + WS_AO);
    bf16_t* HM = (bf16_t*)(ws + WS_HMID);
    const int G = gridDim.x, bid = blockIdx.x;

    unsigned* barw = (unsigned*)(ws + WS_BAR);
    if (bid == 0) for (int i = threadIdx.x; i < XCD_BAR_WORDS; i += 512) barw[i] = 0u;
    if (threadIdx.x < 2) ((LAS unsigned*)(lds + LDS_BARST))[threadIdx.x] = 0u;
    phase_mods(P, lds);
    __syncthreads();
    phase_weights(P, lds);
    grid.sync();
    const XcdBarrier bar = xcd_barrier_post(barw, (volatile LAS unsigned*)(lds + LDS_BARST));
#define GRID_SYNC() xcd_barrier(bar)
    row_phase<false>(MT, P.in[0], P.in[2], nullptr, nullptr, nullptr, nullptr, mod, 0, 1, HB);
    GRID_SYNC();

    for (int layer = 0; layer < 2; ++layer) {
        const int Mrows = layer == 0 ? MT : ML;
        const float* modl = mod + (size_t)layer * 17 * NMODC;
        {
            const int KW = layer == 0 ? 128 : DM;
            pg8::Gemm g{HB, (const bf16_t*)(ws + (layer == 0 ? WS_WQKV0 : WS_WQKV1)), MT, DM + 2 * KW, DM};
            pg8::StaticOrder S; S.init(g.M, g.N, G, bid);
            pg8::EpiQKV E{Qb, Kb, Vb, KW, 0.125f * LOG2E};
            pg8::gemm_phase<pg8::EpiQKV, pg8::StaticOrder, true, true>(lds, g, S, E);
        }
        GRID_SYNC();
        if (layer == 0) attn_window_phase(P, lds); else attn_diff_phase(P, lds);
        GRID_SYNC();
        {
            pg8::Gemm g{AO, (const bf16_t*)(ws + (layer == 0 ? WS_WO0 : WS_WO1)), Mrows, DM, DM};
            pg8::StaticOrder S; S.init(g.M, g.N, G, bid);
            pg8::EpiResid E{layer == 0 ? P.in[0] : P.out, layer == 0 ? P.in[2] : XC, P.out, XC, modl + 2 * DM};
            pg8::gemm_phase<pg8::EpiResid, pg8::StaticOrder, true, true>(lds, g, S, E);
        }
        GRID_SYNC();
        row_phase<true>(Mrows, P.out, XC, P.out, XC, P.in[6] + layer * DM, P.in[7] + layer * DM, modl, 3, 4, HB);
        GRID_SYNC();
        {
            pg8::Gemm g{HB, (const bf16_t*)(ws + (layer == 0 ? WS_W10 : WS_W11)), Mrows, FF, DM};
            pg8::StaticOrder S; S.init(g.M, g.N, G, bid);
            pg8::EpiRelu2 E{HM, FF};
            pg8::gemm_phase<pg8::EpiRelu2, pg8::StaticOrder, true, true>(lds, g, S, E);
        }
        GRID_SYNC();
        {
            pg8::Gemm g{HM, (const bf16_t*)(ws + (layer == 0 ? WS_W20 : WS_W21)), Mrows, DM, FF};
            pg8::StaticOrder S; S.init(g.M, g.N, G, bid);
            pg8::EpiResid E{P.out, XC, P.out, XC, modl + 5 * DM};
            pg8::gemm_phase<pg8::EpiResid, pg8::StaticOrder, true, true>(lds, g, S, E);
        }
        GRID_SYNC();
        row_phase<true>(Mrows, P.out, XC, P.out, XC, P.in[8] + layer * DM, P.in[9] + layer * DM, modl + 17 * NMODC, 0, 1, layer == 0 ? HB : nullptr);
        if (layer == 0) GRID_SYNC();
    }
}

extern "C" void kernel_launch(void* const* d_in, const int* in_sizes, int n_in, void* d_out, int out_size, void* d_ws, size_t ws_size, hipStream_t stream) {
    static int grid_blocks = 0;
    if (grid_blocks == 0) {
        if (n_in != 26 || out_size != ML * DM || ws_size < WS_END) { fprintf(stderr, "kernel_launch: unexpected shapes (n_in %d out %d ws %zu)\n", n_in, out_size, ws_size); grid_blocks = -1; return; }
        int dev = 0, cus = 0, per_cu = 0;
        hipGetDevice(&dev);
        hipDeviceGetAttribute(&cus, hipDeviceAttributeMultiprocessorCount, dev);
        hipFuncSetAttribute((const void*)fwd_megakernel, hipFuncAttributeMaxDynamicSharedMemorySize, LDS_BYTES);
        hipOccupancyMaxActiveBlocksPerMultiprocessor(&per_cu, (const void*)fwd_megakernel, 512, LDS_BYTES);
        if (per_cu < 1) { fprintf(stderr, "kernel_launch: occupancy query reports %d blocks per CU\n", per_cu); per_cu = 1; }
        grid_blocks = cus * per_cu;
        (void)hipGetLastError();
    }
    if (grid_blocks < 0) return;
    Params p{};
    for (int i = 0; i < 26; ++i) p.in[i] = (const float*)d_in[i];
    p.out = (float*)d_out; p.ws = (unsigned char*)d_ws;
    void* args[] = {&p};
    hipError_t e = hipLaunchCooperativeKernel((const void*)fwd_megakernel, dim3(grid_blocks), dim3(512), args, LDS_BYTES, stream);
    if (e != hipSuccess) fprintf(stderr, "cooperative launch failed: %s (grid %d)\n", hipGetErrorString(e), grid_blocks);
}
```

```cpp
#include <hip/hip_runtime.h>
#include <hip/hip_cooperative_groups.h>
#include <cstdio>
#include <cstdint>
namespace cg = cooperative_groups;

constexpr int NB = 16, SEQ = 2048, CTXL = 256, DM = 1024, FF = 4096;
constexpr int ML = NB * SEQ, MC = NB * CTXL, MT = ML + MC;
constexpr int NMODC = 6 * DM;
constexpr float LOG2E = 1.4426950408889634f;
constexpr float DN_ALPHA = 1.4142135623730951f;
constexpr float LAM_INIT = 0.35550906759096926f;

namespace pg8 {
#define PG8_LAS __attribute__((address_space(3)))
typedef unsigned short bf16_t;
typedef short bf16x8 __attribute__((ext_vector_type(8)));
typedef float f32x4 __attribute__((ext_vector_type(4)));
typedef unsigned u32x4 __attribute__((ext_vector_type(4)));
constexpr int BM = 256, BK = 64, HALF = 128, HTB = HALF * BK * 2  , STAGE_BYTES = 8 * HTB, NXCD = 8, WGM = 8;

__host__ __device__ __forceinline__ int lds_byte(int r, int c) { const int st = (r >> 4) * 2 + (c >> 5), rr = r & 15, cc = c & 31, ob = rr * 64 + cc * 2; return st * 1024 + (ob ^ (((ob >> 9) & 1) << 5)); }
__host__ __device__ __forceinline__ void stage_rc(int b, int& R, int& C) { const int st = b / 1024, sb = b % 1024, swz = sb ^ (((sb >> 9) & 1) << 5); R = (st >> 1) * 16 + swz / 64; C = (st & 1) * 32 + (swz % 64) / 2; }
__host__ __device__ __forceinline__ int perm32(int rho) { const int n = rho >> 4, i = rho & 15; return 8 * (i >> 2) + 4 * n + (i & 3); }

struct Unit { int pm, pn; };
struct Gemm { const bf16_t* A; const bf16_t* Bt; int M, N, K; };

struct StaticOrder {
    int nM, nN, nwg, G, c;
    __host__ __device__ void init(int M, int N, int G_, int c_) { nM = M / BM; nN = N / BM; nwg = nM * nN; G = G_; c = c_; }
    __host__ __device__ bool next(int i, Unit& u) const {
        const long L = (long)i * G + c; if (L >= nwg) return false;
        int wgid = (int)L; { const int q = nwg / NXCD, r = nwg % NXCD, xcd = wgid % NXCD, off = wgid / NXCD; wgid = (xcd < r ? xcd * (q + 1) : r * (q + 1) + (xcd - r) * q) + off; }
        const int nig = WGM * nN, gid = wgid / nig, fm = gid * WGM, gsz = (nM - fm) < WGM ? (nM - fm) : WGM;
        u.pm = fm + ((wgid % nig) % gsz); u.pn = (wgid % nig) / gsz; return true;
    }
    __device__ __forceinline__ void a_ready(const Unit&) const {}
    __device__ __forceinline__ void done(const Unit&) const {}
};

__device__ __forceinline__ unsigned cvt_pk_bf16(float lo, float hi) { unsigned r; asm volatile("v_cvt_pk_bf16_f32 %0, %1, %2" : "=v"(r) : "v"(lo), "v"(hi)); return r; }
typedef float f32x2 __attribute__((ext_vector_type(2)));
typedef unsigned u32x2 __attribute__((ext_vector_type(2)));
struct EpiQKV {
    static constexpr bool PERM = true, AFTER_DRAIN = false;
    bf16_t *Q, *Kb, *Vb; int KW; float qscale;
    __device__ __forceinline__ void operator()(const f32x4 (&acc)[2][2][4][2], const Unit& u, int wr, int wc, int fr, int fq) const {
        const int row0 = u.pm * BM + wr * 64 + fr;
        const bool latent = (u.pm * BM) < ML;
        float invf[4];
#pragma unroll
        for (int e = 0; e < 4; ++e) invf[e] = __builtin_amdgcn_exp2f(-(float)(4 * fq + e) * (13.287712379549449f / 16.0f));
#pragma unroll
        for (int bj = 0; bj < 2; ++bj) {
            const int ctile = u.pn * BM + bj * HALF;
            bf16_t* dst; int ld, cbase; bool rope; float sc;
            if (ctile < DM) { dst = Q; ld = DM; cbase = ctile; rope = true; sc = qscale; }
            else if (ctile < DM + KW) { dst = Kb; ld = KW; cbase = ctile - DM; rope = true; sc = 1.f; }
            else { dst = Vb; ld = KW; cbase = ctile - DM - KW; rope = false; sc = 1.f; }
            rope = rope && latent;
            const int col0 = cbase + wc * 32 + 8 * fq;
#pragma unroll
            for (int ai = 0; ai < 2; ++ai)
#pragma unroll
                for (int m = 0; m < 4; ++m) {
                    const int row = row0 + ai * HALF + m * 16;
                    f32x4 v0 = acc[ai][bj][m][0], v1 = acc[ai][bj][m][1];
                    if (rope) {
                        const int t = row & (SEQ - 1);
                        const float pos = (float)((wc & 1) ? (t & 63) : (t >> 6));
                        f32x4 o0, o1;
#pragma unroll
                        for (int e = 0; e < 4; ++e) { const float ang = pos * invf[e]; const float cs = __cosf(ang), sn = __sinf(ang);
                            o0[e] = v0[e] * cs - v1[e] * sn; o1[e] = v0[e] * sn + v1[e] * cs; }
                        v0 = o0; v1 = o1;
                    }
                    v0 = v0 * sc; v1 = v1 * sc;
                    u32x4 w; w.x = cvt_pk_bf16(v0[0], v0[1]); w.y = cvt_pk_bf16(v0[2], v0[3]); w.z = cvt_pk_bf16(v1[0], v1[1]); w.w = cvt_pk_bf16(v1[2], v1[3]);
                    *(u32x4*)(dst + (size_t)row * ld + col0) = w;
                }
        }
    }
};
struct EpiRelu2 {
    static constexpr bool PERM = true, AFTER_DRAIN = false;
    bf16_t* O; int ldc;
    __device__ __forceinline__ void operator()(const f32x4 (&acc)[2][2][4][2], const Unit& u, int wr, int wc, int fr, int fq) const {
        const int row0 = u.pm * BM + wr * 64 + fr, col0 = u.pn * BM + wc * 32 + 8 * fq;
#pragma unroll
        for (int ai = 0; ai < 2; ++ai)
#pragma unroll
            for (int m = 0; m < 4; ++m) { bf16_t* rowp = O + (size_t)(row0 + ai * HALF + m * 16) * ldc + col0;
#pragma unroll
                for (int bj = 0; bj < 2; ++bj) { f32x4 v0 = acc[ai][bj][m][0], v1 = acc[ai][bj][m][1];
#pragma unroll
                    for (int e = 0; e < 4; ++e) { const float a = fmaxf(v0[e], 0.f), b = fmaxf(v1[e], 0.f); v0[e] = a * a; v1[e] = b * b; }
                    u32x4 w; w.x = cvt_pk_bf16(v0[0], v0[1]); w.y = cvt_pk_bf16(v0[2], v0[3]); w.z = cvt_pk_bf16(v1[0], v1[1]); w.w = cvt_pk_bf16(v1[2], v1[3]);
                    *(u32x4*)(rowp + bj * HALF) = w; } }
    }
};
struct EpiResid {
    static constexpr bool PERM = false, AFTER_DRAIN = false;
    const float *xl, *xc; float *yl, *yc; const float* gate;
    __device__ __forceinline__ void operator()(const f32x4 (&acc)[2][2][4][2], const Unit& u, int wr, int wc, int fr, int fq) const {
        const int prow = u.pm * BM;
        const bool latent = prow < ML;
        const float* xin = latent ? xl + (size_t)prow * DM : xc + (size_t)(prow - ML) * DM;
        float* yout = latent ? yl + (size_t)prow * DM : yc + (size_t)(prow - ML) * DM;
        const float* gp = gate + (size_t)(latent ? (prow >> 11) : 16) * NMODC;
        const int col0 = u.pn * BM + wc * 32 + 4 * fq;
        f32x4 gv[2][2];
#pragma unroll
        for (int bj = 0; bj < 2; ++bj)
#pragma unroll
            for (int n = 0; n < 2; ++n) gv[bj][n] = *(const f32x4*)(gp + col0 + bj * HALF + n * 16);
#pragma unroll
        for (int ai = 0; ai < 2; ++ai)
#pragma unroll
            for (int m = 0; m < 4; ++m) { const size_t off = (size_t)(wr * 64 + fr + ai * HALF + m * 16) * DM + col0;
#pragma unroll
                for (int bj = 0; bj < 2; ++bj)
#pragma unroll
                    for (int n = 0; n < 2; ++n) { const f32x4 xv = *(const f32x4*)(xin + off + bj * HALF + n * 16);
                        *(f32x4*)(yout + off + bj * HALF + n * 16) = xv * DN_ALPHA + gv[bj][n] * acc[ai][bj][m][n]; } }
    }
};


template <class Epi, class Sched, bool ALIGN_EPI = false, bool SP2 = false>
__device__ __forceinline__ void gemm_phase(PG8_LAS unsigned char* lds, const Gemm g, const Sched& S, const Epi& E) {
    int tid_ = threadIdx.x; asm volatile("" : "+v"(tid_));
    const int tid = tid_, wid = __builtin_amdgcn_readfirstlane(tid >> 6), lane = tid & 63, wr = wid >> 2, wc = wid & 3, fr = lane & 15, fq = lane >> 4;
    const int K = g.K, nt = K / BK;
    unsigned voffA[2], voffB[2];
#pragma unroll
    for (int i = 0; i < 2; ++i) { int R, C; stage_rc(tid * 16 + i * 8192, R, C); const int Rb = Epi::PERM ? ((R & ~31) + perm32(R & 31)) : R;
        voffA[i] = (unsigned)(R * K + C) * 2u; voffB[i] = (unsigned)(Rb * K + C) * 2u; }
    const size_t kstep = (size_t)(BK * 2);
    const size_t hstep = (size_t)HALF * K * 2;
    const size_t tstep = 2 * hstep;
    const unsigned ldsw = (unsigned)wid * 1024u;
    const int aoff = lds_byte(wr * 64 + fr, fq * 8), boff = lds_byte(wc * 32 + fr, fq * 8);
#define PG8_SA(b, h) (((b) * 2 + (h)) * HTB)
#define PG8_SB(b, h) ((4 + (b) * 2 + (h)) * HTB)
#define PG8_STAGE(bufoff, gbase, voff) do { _Pragma("unroll") for (int _i = 0; _i < 2; ++_i) \
        __builtin_amdgcn_global_load_lds((const unsigned*)((const char*)(gbase) + (voff)[_i]), (PG8_LAS unsigned*)(lds + (bufoff) + ldsw + _i * 8192), 16, 0, 0); } while (0)
#define PG8_LDA(dst, b, h) do { _Pragma("unroll") for (int m = 0; m < 4; ++m) _Pragma("unroll") for (int k = 0; k < 2; ++k) dst[m][k] = *(const PG8_LAS bf16x8*)(lds + PG8_SA(b, h) + aoff + m * 2048 + k * 1024); } while (0)
#define PG8_LDB(dst, b, h) do { _Pragma("unroll") for (int n = 0; n < 2; ++n) _Pragma("unroll") for (int k = 0; k < 2; ++k) dst[n][k] = *(const PG8_LAS bf16x8*)(lds + PG8_SB(b, h) + boff + n * 2048 + k * 1024); } while (0)
#define PG8_MMA(ai, bj, At, Bt) do { __builtin_amdgcn_s_setprio(1); _Pragma("unroll") for (int m = 0; m < 4; ++m) _Pragma("unroll") for (int n = 0; n < 2; ++n) _Pragma("unroll") for (int k = 0; k < 2; ++k) \
        acc[ai][bj][m][n] = __builtin_amdgcn_mfma_f32_16x16x32_bf16(Bt[n][k], At[m][k], acc[ai][bj][m][n], 0, 0, 0); __builtin_amdgcn_s_setprio(0); } while (0)
#define PG8_WAIT_V(n) asm volatile("s_waitcnt vmcnt(" #n ")" ::: "memory")
#define PG8_WAIT_L(n) asm volatile("s_waitcnt lgkmcnt(" #n ")" ::: "memory")
#define PG8_BAR __builtin_amdgcn_s_barrier()
#define PG8_SCHED __builtin_amdgcn_sched_barrier(0)
    Unit cur, nxt; int ui = 0;
    if (!S.next(0, cur)) return;
    f32x4 acc[2][2][4][2];
#pragma unroll
    for (int a = 0; a < 2; ++a)
#pragma unroll
        for (int b = 0; b < 2; ++b)
#pragma unroll
            for (int m = 0; m < 4; ++m)
#pragma unroll
                for (int n = 0; n < 2; ++n) acc[a][b][m][n] = (f32x4){0.f, 0.f, 0.f, 0.f};
    bf16x8 At[4][2], B0[2][2], B1[2][2];
    const char* cA = (const char*)g.A + (size_t)cur.pm * tstep; const char* cB = (const char*)g.Bt + (size_t)cur.pn * tstep;
    S.a_ready(cur);
    if constexpr (SP2) {
        PG8_STAGE(PG8_SB(0, 0), cB, voffB); PG8_STAGE(PG8_SB(0, 1), cB + hstep, voffB); PG8_STAGE(PG8_SA(0, 0), cA, voffA); PG8_STAGE(PG8_SA(0, 1), cA + hstep, voffA);
        if (wr == 1) PG8_BAR;
        PG8_WAIT_V(2); PG8_BAR;
        PG8_STAGE(PG8_SB(1, 0), cB + kstep, voffB); PG8_STAGE(PG8_SA(1, 0), cA + kstep, voffA); PG8_STAGE(PG8_SB(1, 1), cB + hstep + kstep, voffB);
        PG8_WAIT_V(6); PG8_BAR;
    } else {
        PG8_STAGE(PG8_SB(0, 0), cB, voffB); PG8_STAGE(PG8_SA(0, 0), cA, voffA); PG8_STAGE(PG8_SB(0, 1), cB + hstep, voffB); PG8_STAGE(PG8_SA(0, 1), cA + hstep, voffA);
        if (wr == 1) PG8_BAR;
        PG8_WAIT_V(4); PG8_BAR;
        PG8_STAGE(PG8_SB(1, 0), cB + kstep, voffB); PG8_STAGE(PG8_SA(1, 0), cA + kstep, voffA); PG8_STAGE(PG8_SB(1, 1), cB + hstep + kstep, voffB);
        PG8_WAIT_V(6); PG8_BAR;
    }
    for (;;) {
        const bool has_next = S.next(ui + 1, nxt);
        const char* nA = has_next ? (const char*)g.A + (size_t)nxt.pm * tstep : cA; const char* nB = has_next ? (const char*)g.Bt + (size_t)nxt.pn * tstep : cB;
        for (int t = 0; t < nt; t += 2) {
            const bool last = (t == nt - 2);
            const char* a1 = cA + (size_t)(t + 1) * kstep;
            const char* a2 = last ? nA : cA + (size_t)(t + 2) * kstep; const char* b2 = last ? nB : cB + (size_t)(t + 2) * kstep;
            const char* a3 = a2 + kstep; const char* b3 = b2 + kstep;
            if (last && has_next) S.a_ready(nxt);
            if constexpr (SP2) {
            PG8_LDB(B0, 0, 0); PG8_LDB(B1, 0, 1); PG8_SCHED; PG8_LDA(At, 0, 0); PG8_STAGE(PG8_SA(1, 1), a1 + hstep, voffA);
            PG8_WAIT_V(8); PG8_WAIT_L(0); PG8_BAR; PG8_MMA(0, 0, At, B0); PG8_MMA(0, 1, At, B1); PG8_BAR; PG8_SCHED;
            PG8_LDA(At, 0, 1); PG8_STAGE(PG8_SB(0, 0), b2, voffB); PG8_STAGE(PG8_SB(0, 1), b2 + hstep, voffB); PG8_STAGE(PG8_SA(0, 0), a2, voffA);
            PG8_WAIT_V(8); PG8_WAIT_L(0); PG8_BAR; PG8_MMA(1, 0, At, B0); PG8_MMA(1, 1, At, B1); PG8_BAR; PG8_SCHED;
            PG8_LDB(B0, 1, 0); PG8_LDB(B1, 1, 1); PG8_SCHED; PG8_LDA(At, 1, 0); PG8_STAGE(PG8_SA(0, 1), a2 + hstep, voffA);
            PG8_WAIT_V(8); PG8_WAIT_L(0); PG8_BAR; PG8_MMA(0, 0, At, B0); PG8_MMA(0, 1, At, B1); PG8_BAR; PG8_SCHED;
            PG8_LDA(At, 1, 1); PG8_STAGE(PG8_SB(1, 0), b3, voffB); PG8_STAGE(PG8_SB(1, 1), b3 + hstep, voffB); PG8_STAGE(PG8_SA(1, 0), a3, voffA);
            PG8_WAIT_V(8); PG8_WAIT_L(0); PG8_BAR; PG8_MMA(1, 0, At, B0); PG8_MMA(1, 1, At, B1); PG8_BAR; PG8_SCHED;
            } else {
            PG8_LDB(B0, 0, 0); PG8_SCHED; PG8_LDA(At, 0, 0); PG8_STAGE(PG8_SA(1, 1), a1 + hstep, voffA);
            PG8_WAIT_L(8); PG8_BAR; PG8_WAIT_L(0); PG8_MMA(0, 0, At, B0); PG8_BAR; PG8_SCHED;
            PG8_LDB(B1, 0, 1); PG8_STAGE(PG8_SB(0, 0), b2, voffB);
            PG8_BAR; PG8_WAIT_L(0); PG8_MMA(0, 1, At, B1); PG8_BAR;
            PG8_LDA(At, 0, 1); PG8_STAGE(PG8_SA(0, 0), a2, voffA);
            PG8_BAR; PG8_WAIT_L(0); PG8_MMA(1, 0, At, B0); PG8_BAR; PG8_SCHED;
            PG8_STAGE(PG8_SB(0, 1), b2 + hstep, voffB);
            PG8_WAIT_V(6); PG8_BAR; PG8_MMA(1, 1, At, B1); PG8_BAR;
            PG8_LDB(B0, 1, 0); PG8_SCHED; PG8_LDA(At, 1, 0); PG8_STAGE(PG8_SA(0, 1), a2 + hstep, voffA);
            PG8_WAIT_L(8); PG8_BAR; PG8_WAIT_L(0); PG8_MMA(0, 0, At, B0); PG8_BAR; PG8_SCHED;
            PG8_LDB(B1, 1, 1); PG8_STAGE(PG8_SB(1, 0), b3, voffB);
            PG8_BAR; PG8_WAIT_L(0); PG8_MMA(0, 1, At, B1); PG8_BAR;
            PG8_LDA(At, 1, 1); PG8_STAGE(PG8_SA(1, 0), a3, voffA);
            PG8_BAR; PG8_WAIT_L(0); PG8_MMA(1, 0, At, B0); PG8_BAR; PG8_SCHED;
            PG8_STAGE(PG8_SB(1, 1), b3 + hstep, voffB);
            PG8_WAIT_V(6); PG8_BAR; PG8_MMA(1, 1, At, B1); PG8_BAR;
            }
        }
        if constexpr (ALIGN_EPI) { if (wr == 0) PG8_BAR; }
        if constexpr (!Epi::AFTER_DRAIN) { E(acc, cur, wr, wc, fr, fq); S.done(cur); }
        if (!has_next) break;
#pragma unroll
        for (int a = 0; a < 2; ++a)
#pragma unroll
            for (int b = 0; b < 2; ++b)
#pragma unroll
                for (int m = 0; m < 4; ++m)
#pragma unroll
                    for (int n = 0; n < 2; ++n) acc[a][b][m][n] = (f32x4){0.f, 0.f, 0.f, 0.f};
        cur = nxt; cA = nA; cB = nB; ++ui;
        if constexpr (ALIGN_EPI) { if (wr == 1) PG8_BAR; }
    }
    PG8_WAIT_V(0);
    if constexpr (!ALIGN_EPI) { if (wr == 0) PG8_BAR; }
    PG8_BAR;
    if constexpr (Epi::AFTER_DRAIN) { E.fused(acc, cur, wr, wc, fr, fq, lds, wid, lane); S.done(cur); }
#undef PG8_SA
#undef PG8_SB
#undef PG8_STAGE
#undef PG8_LDA
#undef PG8_LDB
#undef PG8_MMA
#undef PG8_WAIT_V
#undef PG8_WAIT_L
#undef PG8_BAR
#undef PG8_SCHED
}
}
#define LAS __attribute__((address_space(3)))
typedef unsigned short bf16_t;
typedef short bf16x8 __attribute__((ext_vector_type(8)));
typedef short s16x4 __attribute__((ext_vector_type(4)));
typedef float f32x4 __attribute__((ext_vector_type(4)));
typedef float f32x16 __attribute__((ext_vector_type(16)));
typedef unsigned u32x4 __attribute__((ext_vector_type(4)));
typedef unsigned u32x2 __attribute__((ext_vector_type(2)));
typedef float f32x2_t __attribute__((ext_vector_type(2)));
typedef __bf16 bf16x2_t __attribute__((ext_vector_type(2)));

constexpr size_t MiB = 1u << 20;
constexpr size_t WS_MISC = 0, WS_MOD = 1 * MiB;
constexpr size_t WS_WQKV0 = 2 * MiB, WS_WO0 = 5 * MiB, WS_W10 = 8 * MiB, WS_W20 = 16 * MiB;
constexpr size_t WS_WQKV1 = 24 * MiB, WS_WO1 = 30 * MiB, WS_W11 = 32 * MiB, WS_W21 = 40 * MiB;
constexpr size_t WS_XC = 48 * MiB;
constexpr size_t WS_HB = 64 * MiB;
constexpr size_t WS_Q = 136 * MiB, WS_K = 208 * MiB, WS_V = 280 * MiB, WS_AO = 352 * MiB;
constexpr size_t WS_HMID = 136 * MiB;
constexpr size_t WS_END = 424 * MiB;
constexpr int LDS_BYTES = 147456;

struct Params { const float* in[26]; float* out; unsigned char* ws; };
constexpr size_t WS_BAR = 65536;
constexpr int LDS_BARST = 131072 + 64;
#define XB_TMO      128
#define XB_XCNT(j)  (256  + 64 * (j))
#define XB_XSUB(j)  (1280 + 64 * (j))
#define XB_XGEN(j)  (2304 + 64 * (j))
#define XB_TOP      3328
#define XB_TOPGEN   3392
#define XCD_BAR_WORDS 3456
#define XB_SPIN_CAP (1u << 18)

__device__ __forceinline__ unsigned xb_ld(unsigned* p)              { return __hip_atomic_load(p, __ATOMIC_RELAXED, __HIP_MEMORY_SCOPE_AGENT); }
__device__ __forceinline__ unsigned xb_add(unsigned* p, unsigned v) { return __hip_atomic_fetch_add(p, v, __ATOMIC_RELAXED, __HIP_MEMORY_SCOPE_AGENT); }
__device__ __forceinline__ unsigned xb_xcc_id() { return (unsigned)__builtin_amdgcn_s_getreg((3 << 11) | 20) & 0xFu; }
#define XB_SPIN(cond, bar) do { unsigned _sp = 0; while (cond) { __builtin_amdgcn_s_sleep(1); \
    if ((++_sp & 255u) == 0u) { if (xb_ld(&(bar)[XB_TMO])) break; if (_sp > XB_SPIN_CAP) { atomicAdd(&(bar)[XB_TMO], 1u); break; } } } } while (0)

struct XcdBarrier {
    unsigned* bar; unsigned x;
    volatile LAS unsigned* st;
};

__device__ __forceinline__ XcdBarrier xcd_barrier_post(unsigned* bar, volatile LAS unsigned* st) {
    XcdBarrier b; b.bar = bar; b.x = xb_xcc_id(); b.st = st;
    if (threadIdx.x == 0) (void)xb_add(&bar[XB_XCNT(b.x)], 1u);
    return b;
}
__device__ __forceinline__ void xcd_barrier_complete(unsigned* bar, unsigned x, unsigned& nloc, unsigned& nx) {
    const unsigned G = gridDim.x * gridDim.y * gridDim.z;
    unsigned sum, cnt, mine, sp = 0u;
    for (;;) {
        sum = 0u; cnt = 0u; mine = 0u;
#pragma unroll
        for (unsigned j = 0; j < 16; ++j) { const unsigned c = xb_ld(&bar[XB_XCNT(j)]); sum += c; cnt += (c > 0u) ? 1u : 0u; mine = (j == x) ? c : mine; }
        if (sum == G) break;
        __builtin_amdgcn_s_sleep(1);
        if ((++sp & 255u) == 0u) { if (xb_ld(&bar[XB_TMO])) break; if (sp > XB_SPIN_CAP) { atomicAdd(&bar[XB_TMO], 1u); break; } }
    }
    nloc = mine > 0u ? mine : 1u; nx = cnt > 0u ? cnt : 1u;
}

__device__ __forceinline__ void xcd_barrier(const XcdBarrier& b) {
    asm volatile("s_waitcnt vmcnt(0)" ::: "memory");
    __syncthreads();
    if (threadIdx.x == 0) {
        unsigned* bar = b.bar;
        __builtin_amdgcn_s_waitcnt(0);
        unsigned nloc = b.st[0], nx = b.st[1];
        if (nloc == 0u) { xcd_barrier_complete(bar, b.x, nloc, nx); b.st[0] = nloc; b.st[1] = nx; }
        const unsigned old = xb_add(&bar[XB_XSUB(b.x)], 1u);
        const unsigned gen = old / nloc;
        if (old + 1u == (gen + 1u) * nloc) {
            __builtin_amdgcn_fence(__ATOMIC_RELEASE, "agent");
            asm volatile("s_waitcnt vmcnt(0)" ::: "memory");
            const unsigned og = xb_add(&bar[XB_TOP], 1u);
            const unsigned tg = og / nx;
            if (og + 1u == (tg + 1u) * nx) xb_add(&bar[XB_TOPGEN], 1u);
            else XB_SPIN(xb_ld(&bar[XB_TOPGEN]) == tg, bar);
            __builtin_amdgcn_fence(__ATOMIC_ACQUIRE, "agent");
            xb_add(&bar[XB_XGEN(b.x)], 1u);
            asm volatile("s_waitcnt vmcnt(0)" ::: "memory");
        } else {
            XB_SPIN(xb_ld(&bar[XB_XGEN(b.x)]) == gen, bar);
            __builtin_amdgcn_fence(__ATOMIC_ACQUIRE, "agent");
            asm volatile("s_waitcnt vmcnt(0)" ::: "memory");
        }
    }
    __syncthreads();
}


__device__ __forceinline__ unsigned pk2(float lo, float hi) { f32x2_t v = {lo, hi}; bf16x2_t b = __builtin_convertvector(v, bf16x2_t); return __builtin_bit_cast(unsigned, b); }
__device__ __forceinline__ float wave_sum(float v) {
#pragma unroll
    for (int o = 1; o < 64; o <<= 1) v += __shfl_xor(v, o);
    return v;
}
__device__ __forceinline__ float half_max(float m) { auto rr = __builtin_amdgcn_permlane32_swap(__float_as_uint(m), __float_as_uint(m), false, false); return fmaxf(__uint_as_float(rr[0]), __uint_as_float(rr[1])); }
__device__ __forceinline__ float half_sum(float m) { auto rr = __builtin_amdgcn_permlane32_swap(__float_as_uint(m), __float_as_uint(m), false, false); return __uint_as_float(rr[0]) + __uint_as_float(rr[1]); }
__device__ __forceinline__ s16x4 vtr(LAS const unsigned char* p) { typedef short v4i16_t __attribute__((ext_vector_type(4))); return __builtin_bit_cast(s16x4, __builtin_amdgcn_ds_read_tr16_b64_v4i16((LAS v4i16_t*)p)); }

__device__ __forceinline__ void phase_mods(const Params& P, LAS unsigned char* lds) {
    int tid_ = threadIdx.x; asm volatile("" : "+v"(tid_));
    const int tid = tid_, lane = tid & 63, wave = __builtin_amdgcn_readfirstlane(tid >> 6);
    float* mod = (float*)(P.ws + WS_MOD);
    if (blockIdx.x == gridDim.x - 1 && tid == 0) {
        float s1 = 0.f, s2 = 0.f;
        for (int i = 0; i < 64; ++i) { s1 += P.in[19][i] * P.in[20][i]; s2 += P.in[21][i] * P.in[22][i]; }
        ((float*)(P.ws + WS_MISC))[0] = __expf(s1) - __expf(s2) + LAM_INIT;
    }
    if (blockIdx.x >= 192) return;
    LAS float* S = (LAS float*)lds;
    LAS float* red = (LAS float*)(lds + 17 * 1024 * 4);
    for (int i = tid; i < 17 * 1024; i += 512) { const int r = i >> 10, k = i & 1023; const float v = r < 16 ? P.in[1][r * 1024 + k] : P.in[3][k]; S[i] = v / (1.f + __expf(-v)); }
    __syncthreads();
    for (int u = blockIdx.x; u < 192; u += gridDim.x) {
        const int l = u / 96, g = u % 96, n = g * 64 + lane;
        const float* W = P.in[4] + (size_t)l * DM * NMODC + n;
        float acc[17];
#pragma unroll
        for (int r = 0; r < 17; ++r) acc[r] = 0.f;
        const int k0 = wave * 128;
#pragma unroll 2
        for (int k = k0; k < k0 + 128; k += 4) {
            const float w0 = W[(size_t)k * NMODC], w1 = W[(size_t)(k + 1) * NMODC], w2 = W[(size_t)(k + 2) * NMODC], w3 = W[(size_t)(k + 3) * NMODC];
#pragma unroll
            for (int r = 0; r < 17; ++r) { const f32x4 s = *(const LAS f32x4*)(S + r * 1024 + k); acc[r] += (w0 * s.x + w1 * s.y) + (w2 * s.z + w3 * s.w); }
        }
#pragma unroll
        for (int r = 0; r < 17; ++r) red[(wave * 17 + r) * 64 + lane] = acc[r];
        __syncthreads();
        for (int idx = tid; idx < 17 * 64; idx += 512) { const int r = idx >> 6, ln = idx & 63; float s = 0.f;
#pragma unroll
            for (int w = 0; w < 8; ++w) s += red[(w * 17 + r) * 64 + ln];
            const int nn = g * 64 + ln; mod[(size_t)(l * 17 + r) * NMODC + nn] = s + P.in[5][l * NMODC + nn]; }
        __syncthreads();
    }
}
__device__ __forceinline__ unsigned f2bf(float f) { unsigned u = __builtin_bit_cast(unsigned, f); return (u + 0x7fffu + ((u >> 16) & 1u)) >> 16; }
__device__ __forceinline__ unsigned pk2i(float lo, float hi) { return f2bf(lo) | (f2bf(hi) << 16); }
__device__ __forceinline__ void transpose_item(const float* W, int K, int N, bf16_t* WT, int row_off, bool perm, LAS float* scr, int item, int lane) {
    const int nblk = N / 32, kb = item / nblk, nb = item % nblk, k0 = 64 * kb, n0 = 32 * nb;
    int sp = n0 + (lane & 31);
    if (perm) { const int p = sp & 63; sp = (sp & ~63) + 16 * (p >> 5) + 4 * ((p >> 3) & 3) + (p & 3) + 32 * ((p >> 2) & 1); }
#pragma unroll 8
    for (int i = 0; i < 32; ++i) { const int kk = 2 * i + (lane >> 5); scr[kk * 33 + (lane & 31)] = W[(size_t)(k0 + kk) * N + sp]; }
    asm volatile("s_waitcnt lgkmcnt(0)" ::: "memory");
    const int c = lane & 7;
#pragma unroll
    for (int j = 0; j < 4; ++j) { const int n = (lane >> 3) + 8 * j; const LAS float* s = scr + (8 * c) * 33 + n;
        u32x4 o; o.x = pk2i(s[0 * 33], s[1 * 33]); o.y = pk2i(s[2 * 33], s[3 * 33]); o.z = pk2i(s[4 * 33], s[5 * 33]); o.w = pk2i(s[6 * 33], s[7 * 33]);
        *(u32x4*)(WT + (size_t)(row_off + n0 + n) * K + k0 + 8 * c) = o; }
    asm volatile("s_waitcnt lgkmcnt(0)" ::: "memory");
}
__device__ __forceinline__ void phase_weights(const Params& P, LAS unsigned char* lds) {
    int tid_ = threadIdx.x; asm volatile("" : "+v"(tid_));
    const int lane = tid_ & 63, wave = __builtin_amdgcn_readfirstlane(tid_ >> 6);
    LAS float* scr = (LAS float*)(lds + wave * 16384);
    const int gw = blockIdx.x * 8 + wave, NGW = gridDim.x * 8;
    unsigned char* ws = P.ws;
    constexpr int I_DD = 16 * 32, I_DK0 = 16 * 4, I_1 = 16 * 128, I_2 = 64 * 32;
    constexpr int NITEMS = (I_DD + 2 * I_DK0 + I_DD + I_1 + I_2) + (4 * I_DD + I_1 + I_2);
    for (int it = gw; it < NITEMS; it += NGW) {
        int r = it;
#define TR_ITEM(cnt, W, K, N, WT, roff, perm) if (r < (cnt)) { transpose_item((W), (K), (N), (bf16_t*)(ws + (WT)), (roff), (perm), scr, r, lane); continue; } r -= (cnt);
        TR_ITEM(I_DD,  P.in[10], DM, DM,  WS_WQKV0, 0, true)
        TR_ITEM(I_DK0, P.in[11], DM, 128, WS_WQKV0, DM, true)
        TR_ITEM(I_DK0, P.in[12], DM, 128, WS_WQKV0, DM + 128, false)
        TR_ITEM(I_DD,  P.in[13], DM, DM,  WS_WO0, 0, false)
        TR_ITEM(I_1,   P.in[24], DM, FF,  WS_W10, 0, false)
        TR_ITEM(I_2,   P.in[25], FF, DM,  WS_W20, 0, false)
        TR_ITEM(I_DD,  P.in[15], DM, DM,  WS_WQKV1, 0, true)
        TR_ITEM(I_DD,  P.in[16], DM, DM,  WS_WQKV1, DM, true)
        TR_ITEM(I_DD,  P.in[17], DM, DM,  WS_WQKV1, 2 * DM, false)
        TR_ITEM(I_DD,  P.in[18], DM, DM,  WS_WO1, 0, false)
        TR_ITEM(I_1,   P.in[24] + (size_t)DM * FF, DM, FF, WS_W11, 0, false)
        TR_ITEM(I_2,   P.in[25] + (size_t)FF * DM, FF, DM, WS_W21, 0, false)
#undef TR_ITEM
    }
}
template <bool DO_LN>
__device__ __forceinline__ void row_phase(int nrows, const float* srcL, const float* srcC, float* dstL, float* dstC, const float* lng, const float* lnb,
                                          const float* modl  , int sh_chunk, int sc_chunk, bf16_t* HB) {
    int tid_ = threadIdx.x; asm volatile("" : "+v"(tid_));
    const int lane = tid_ & 63, wave = __builtin_amdgcn_readfirstlane(tid_ >> 6);
    const int gw = blockIdx.x * 8 + wave, NGW = gridDim.x * 8;
    for (int row = gw; row < nrows; row += NGW) {
        const bool latent = row < ML;
        const size_t roff = latent ? (size_t)row * DM : (size_t)(row - ML) * DM;
        const f32x4* xr = (const f32x4*)((latent ? srcL : srcC) + roff) + lane;
        f32x4 v[4];
#pragma unroll
        for (int j = 0; j < 4; ++j) v[j] = xr[64 * j];
        if (DO_LN) {
            float s = 0.f;
#pragma unroll
            for (int j = 0; j < 4; ++j) s += (v[j].x + v[j].y) + (v[j].z + v[j].w);
            const float mean = wave_sum(s) * (1.f / DM); float s2 = 0.f;
#pragma unroll
            for (int j = 0; j < 4; ++j) { v[j] = v[j] - mean; s2 += (v[j].x * v[j].x + v[j].y * v[j].y) + (v[j].z * v[j].z + v[j].w * v[j].w); }
            const float rstd = 1.f / sqrtf(wave_sum(s2) * (1.f / DM) + 1e-5f);
            f32x4* yr = (f32x4*)((latent ? dstL : dstC) + roff) + lane;
#pragma unroll
            for (int j = 0; j < 4; ++j) { const f32x4 g = ((const f32x4*)lng)[lane + 64 * j], b = ((const f32x4*)lnb)[lane + 64 * j]; v[j] = v[j] * rstd * g + b; yr[64 * j] = v[j]; }
        }
        if (HB) {
            const float* mrow = modl + (size_t)(latent ? (row >> 11) : 16) * NMODC;
            u32x2* hr = (u32x2*)(HB + (size_t)row * DM) + lane;
#pragma unroll
            for (int j = 0; j < 4; ++j) { const f32x4 sh = ((const f32x4*)(mrow + sh_chunk * DM))[lane + 64 * j], sc = ((const f32x4*)(mrow + sc_chunk * DM))[lane + 64 * j];
                const f32x4 h = v[j] * (sc + 1.0f) + sh; u32x2 w; w.x = pk2(h.x, h.y); w.y = pk2(h.z, h.w); hr[64 * j] = w; }
        }
    }
}
#define MFMA32(a, b, c) __builtin_amdgcn_mfma_f32_32x32x16_bf16((a), (b), (c), 0, 0, 0)
__device__ __forceinline__ float max3f(float a, float b, float c) { float r; asm("v_max3_f32 %0, %1, %2, %3" : "=v"(r) : "v"(a), "v"(b), "v"(c)); return r; }
__device__ __forceinline__ float max2f(float a, float b) { float r; asm("v_max_f32_e32 %0, %1, %2" : "=v"(r) : "v"(a), "v"(b)); return r; }
__device__ __forceinline__ float half_max2(float m) { auto rr = __builtin_amdgcn_permlane32_swap(__float_as_uint(m), __float_as_uint(m), false, false); return max2f(__uint_as_float(rr[0]), __uint_as_float(rr[1])); }
template <int ND, bool NEXT>
__device__ __forceinline__ void softmax_tile(f32x16& p0, f32x16& p1, f32x16& n0, f32x16& n1, f32x16& negm, float& m, float& l, f32x16 (&o)[ND], bf16x8 (&pb)[2][2], bool first) {
    float a = max3f(p0[0], p0[1], p1[0]), b = max3f(p0[2], p0[3], p1[1]); a = max3f(a, p1[2], p1[3]);
#pragma unroll
    for (int i = 4; i < 16; i += 4) { a = max3f(a, p0[i], p0[i + 1]); b = max3f(b, p0[i + 2], p0[i + 3]); a = max3f(a, p1[i], p1[i + 1]); b = max3f(b, p1[i + 2], p1[i + 3]); }
    const float mx = half_max2(max2f(a, b));
    if (first || __builtin_amdgcn_ballot_w64(mx > 8.0f) != 0ull) {
        const float up = first ? mx : max2f(mx, 0.f);
        if (!first) { const float alpha = __builtin_amdgcn_exp2f(-up); l *= alpha;
#pragma unroll
            for (int d = 0; d < ND; ++d) o[d] = o[d] * alpha; }
        m += up;
        p0 = p0 - up; p1 = p1 - up; negm = negm - up;
        if (NEXT) { n0 = n0 - up; n1 = n1 - up; }
    }
    float rs = 0.f;
#pragma unroll
    for (int i = 0; i < 16; ++i) { p0[i] = __builtin_amdgcn_exp2f(p0[i]); p1[i] = __builtin_amdgcn_exp2f(p1[i]); rs += p0[i] + p1[i]; }
    l += rs;
#pragma unroll
    for (int s = 0; s < 2; ++s) {
        u32x4 w0, w1;
        w0.x = pk2(p0[8 * s + 0], p0[8 * s + 1]); w0.y = pk2(p0[8 * s + 2], p0[8 * s + 3]); w0.z = pk2(p0[8 * s + 4], p0[8 * s + 5]); w0.w = pk2(p0[8 * s + 6], p0[8 * s + 7]);
        w1.x = pk2(p1[8 * s + 0], p1[8 * s + 1]); w1.y = pk2(p1[8 * s + 2], p1[8 * s + 3]); w1.z = pk2(p1[8 * s + 4], p1[8 * s + 5]); w1.w = pk2(p1[8 * s + 6], p1[8 * s + 7]);
        pb[0][s] = __builtin_bit_cast(bf16x8, w0); pb[1][s] = __builtin_bit_cast(bf16x8, w1);
    }
}
#define SCHED_FENCE() __builtin_amdgcn_sched_barrier(0)
template <int ND, int VS>
__device__ __forceinline__ void pv_load(s16x4 (&v)[2][2], LAS const unsigned char* vb, int voff, int g) {
    const int ks = g / (ND / 2), dh = g % (ND / 2);
    LAS const unsigned char* a = vb + voff + ((ks >> 1) * 32 + (ks & 1) * 16) * VS + dh * 128;
#pragma unroll
    for (int j = 0; j < 2; ++j) { v[j][0] = vtr(a + j * 64); v[j][1] = vtr(a + 8 * VS + j * 64); }
}
template <int ND>
__device__ __forceinline__ void pv_mma(f32x16 (&o)[ND], const s16x4 (&v)[2][2], const bf16x8 (&pb)[2][2], int g) {
    const int ks = g / (ND / 2), dh = g % (ND / 2);
#pragma unroll
    for (int j = 0; j < 2; ++j) { const bf16x8 vf = {v[j][0][0], v[j][0][1], v[j][0][2], v[j][0][3], v[j][1][0], v[j][1][1], v[j][1][2], v[j][1][3]};
        o[2 * dh + j] = MFMA32(vf, pb[ks >> 1][ks & 1], o[2 * dh + j]); }
}
template <int ND, int VS>
__device__ __forceinline__ void pv_rest(f32x16 (&o)[ND], s16x4 (&vA)[2][2], const bf16x8 (&pb)[2][2], LAS const unsigned char* vb, int voff) {
    s16x4 vB[2][2];
#pragma unroll
    for (int g = 0; g < 2 * ND; g += 2) {
        pv_load<ND, VS>(vB, vb, voff, g + 1); SCHED_FENCE(); pv_mma<ND>(o, vA, pb, g); SCHED_FENCE();
        if (g + 2 < 2 * ND) { pv_load<ND, VS>(vA, vb, voff, g + 2); SCHED_FENCE(); }
        pv_mma<ND>(o, vB, pb, g + 1); SCHED_FENCE();
    }
}

__device__ __forceinline__ void attn_window_phase(const Params& P, LAS unsigned char* lds) {
    constexpr int KS = 144, VS = 192, STAGE = 64 * KS + 64 * VS;
    int tid_ = threadIdx.x; asm volatile("" : "+v"(tid_));
    const int tid = tid_, lane = tid & 63, wave = __builtin_amdgcn_readfirstlane(tid >> 6), r = lane & 31, hi = lane >> 5;
    const bf16_t* Q = (const bf16_t*)(P.ws + WS_Q); const bf16_t* Kg = (const bf16_t*)(P.ws + WS_K); const bf16_t* Vg = (const bf16_t*)(P.ws + WS_V);
    bf16_t* AO = (bf16_t*)(P.ws + WS_AO);
    const int voff = (4 * hi + ((lane & 15) >> 2)) * VS + (16 * ((lane >> 4) & 1) + 4 * (lane & 3)) * 2;
    const int lkey = tid >> 3, lch = tid & 7;
    for (int u = blockIdx.x; u < 2304; u += gridDim.x) {
        int b, hk, sb; bool isctx;
        if (u < 2048) { const int c = u & 255, i = u >> 8; b = i * 2 + (c & 1); hk = (c >> 1) & 1; sb = c >> 2; isctx = false; }
        else { const int c = u - 2048; b = c & 15; hk = (c >> 4) & 1; sb = c >> 5; isctx = true; }
        const int q0 = sb * 32;
        const int qrow0 = isctx ? ML + b * CTXL + q0 : b * SEQ + q0;
        int klo = 0, nlat = 0;
        if (!isctx) { klo = (q0 - 128 > 0 ? q0 - 128 : 0) & ~63; int khi = (q0 + 160 + 63) & ~63; if (khi > SEQ) khi = SEQ; nlat = (khi - klo) >> 6; }
        const int nt = nlat + 4;
        const int h = hk * 8 + wave;
        bf16x8 qf[4];
        { const bf16_t* qp = Q + (size_t)(qrow0 + r) * DM + h * 64 + 8 * hi;
#pragma unroll
          for (int d0 = 0; d0 < 4; ++d0) qf[d0] = *(const bf16x8*)(qp + d0 * 16); }
        float m = P.in[14][h] * LOG2E, l = hi ? 0.f : 1.f;
        f32x16 o[2], negm;
#pragma unroll
        for (int i = 0; i < 16; ++i) { o[0][i] = 0.f; o[1][i] = 0.f; negm[i] = -m; }
        u32x4 kreg, vreg;
#define TILE_ROW0(t) ((t) < nlat ? b * SEQ + klo + (t) * 64 : ML + b * CTXL + ((t) - nlat) * 64)
#define LOAD_TILE0(t) do { const size_t go = (size_t)(TILE_ROW0(t) + lkey) * 128 + hk * 64 + lch * 8; kreg = *(const u32x4*)(Kg + go); vreg = *(const u32x4*)(Vg + go); } while (0)
#define STORE_TILE0(st) do { *(LAS u32x4*)((st) + lkey * KS + lch * 16) = kreg; *(LAS u32x4*)((st) + 64 * KS + lkey * VS + lch * 16) = vreg; } while (0)
#define QK_TILE0(st, a0, a1) do { _Pragma("unroll") for (int d0 = 0; d0 < 4; ++d0) { \
                const bf16x8 k0 = *(const LAS bf16x8*)((st) + r * KS + d0 * 32 + hi * 16), k1 = *(const LAS bf16x8*)((st) + (32 + r) * KS + d0 * 32 + hi * 16); \
                a0 = MFMA32(k0, qf[d0], d0 == 0 ? negm : a0); a1 = MFMA32(k1, qf[d0], d0 == 0 ? negm : a1); } } while (0)
        LOAD_TILE0(0); STORE_TILE0(lds); LOAD_TILE0(1); STORE_TILE0(lds + STAGE); __syncthreads();
        f32x16 pc0, pc1;
        QK_TILE0(lds, pc0, pc1);
        int oc = 0, on = STAGE, ow = 2 * STAGE;
        for (int t = 0; t < nt; ++t) {
            if (t + 2 < nt) LOAD_TILE0(t + 2);
            f32x16 pn0, pn1;
            QK_TILE0(lds + on, pn0, pn1);
            s16x4 vA[2][2];
            pv_load<2, VS>(vA, lds + oc + 64 * KS, voff, 0); SCHED_FENCE();
            if (t < nlat) {
                const int D = klo + t * 64 - q0;
                const int dbase = D + 4 * hi - r;
                if (D < -97 || D > 65) {
#pragma unroll
                    for (int i = 0; i < 16; ++i) { const int d = dbase + (i & 3) + 8 * (i >> 2);
                        if (d > 128 || d < -128) pc0[i] = -1e30f;
                        if (d + 32 > 128 || d + 32 < -128) pc1[i] = -1e30f; }
                }
            }
            bf16x8 pb[2][2];
            softmax_tile<2, true>(pc0, pc1, pn0, pn1, negm, m, l, o, pb, false);
            SCHED_FENCE();
            pv_rest<2, VS>(o, vA, pb, lds + oc + 64 * KS, voff);
            if (t + 2 < nt) STORE_TILE0(lds + ow);
            __syncthreads();
            pc0 = pn0; pc1 = pn1;
            const int tmpo = oc; oc = on; on = ow; ow = tmpo;
        }
#undef TILE_ROW0
#undef LOAD_TILE0
#undef STORE_TILE0
#undef QK_TILE0
        const float inv = 1.f / half_sum(l);
        bf16_t* op = AO + (size_t)(qrow0 + r) * DM + h * 64 + 4 * hi;
#pragma unroll
        for (int d0 = 0; d0 < 2; ++d0)
#pragma unroll
            for (int tq = 0; tq < 4; ++tq) { u32x2 w; w.x = pk2(o[d0][4 * tq] * inv, o[d0][4 * tq + 1] * inv); w.y = pk2(o[d0][4 * tq + 2] * inv, o[d0][4 * tq + 3] * inv);
                *(u32x2*)(op + d0 * 32 + 8 * tq) = w; }
    }
}

__device__ __forceinline__ void attn_diff_phase(const Params& P, LAS unsigned char* lds) {
    constexpr int KS = 272, VS = 320, STAGE = 64 * KS + 64 * VS;
    int tid_ = threadIdx.x; asm volatile("" : "+v"(tid_));
    const int tid = tid_, lane = tid & 63, wave = __builtin_amdgcn_readfirstlane(tid >> 6), r = lane & 31, hi = lane >> 5;
    const int tmap = wave >> 2, sq = wave & 3;
    const bf16_t* Q = (const bf16_t*)(P.ws + WS_Q); const bf16_t* Kg = (const bf16_t*)(P.ws + WS_K); const bf16_t* Vg = (const bf16_t*)(P.ws + WS_V);
    bf16_t* AO = (bf16_t*)(P.ws + WS_AO);
    const float lam = ((const float*)(P.ws + WS_MISC))[0];
    const float* subg = P.in[23];
    const int voff = (4 * hi + ((lane & 15) >> 2)) * VS + (16 * ((lane >> 4) & 1) + 4 * (lane & 3)) * 2;
    const int lkey = tid >> 4, lch = tid & 15;
    LAS float* xch = (LAS float*)lds;
    if (tmap == 0) __builtin_amdgcn_s_setprio(1);
    for (int u = blockIdx.x; u < 2048; u += gridDim.x) {
        const int c = u & 255, i = u >> 8; const int h = c & 7, qb = (c >> 3) & 15, b = i * 2 + (c >> 7);
        const int qrow0 = b * SEQ + qb * 128 + sq * 32;
        bf16x8 qf[4];
        { const bf16_t* qp = Q + (size_t)(qrow0 + r) * DM + (h * 2 + tmap) * 64 + 8 * hi;
#pragma unroll
          for (int d0 = 0; d0 < 4; ++d0) qf[d0] = *(const bf16x8*)(qp + d0 * 16); }
        float m = 0.f, l = 0.f;
        f32x16 o[4], negm;
#pragma unroll
        for (int i2 = 0; i2 < 16; ++i2) { negm[i2] = 0.f;
#pragma unroll
            for (int d = 0; d < 4; ++d) o[d][i2] = 0.f; }
        u32x4 kreg[2], vreg[2];
#define TILE_ROW1(t) ((t) < 32 ? b * SEQ + (t) * 64 : ML + b * CTXL + ((t) - 32) * 64)
#define LOAD_TILE1(t) do { const size_t go = (size_t)(TILE_ROW1(t) + lkey) * DM + h * 128 + lch * 8; kreg[0] = *(const u32x4*)(Kg + go); vreg[0] = *(const u32x4*)(Vg + go); \
                           kreg[1] = *(const u32x4*)(Kg + go + 32 * DM); vreg[1] = *(const u32x4*)(Vg + go + 32 * DM); } while (0)
#define STORE_TILE1(st) do { *(LAS u32x4*)((st) + lkey * KS + lch * 16) = kreg[0]; *(LAS u32x4*)((st) + (lkey + 32) * KS + lch * 16) = kreg[1]; \
                             *(LAS u32x4*)((st) + 64 * KS + lkey * VS + lch * 16) = vreg[0]; *(LAS u32x4*)((st) + 64 * KS + (lkey + 32) * VS + lch * 16) = vreg[1]; } while (0)
#define QK_TILE1(st, a0, a1) do { _Pragma("unroll") for (int d0 = 0; d0 < 4; ++d0) { \
                const bf16x8 k0 = *(const LAS bf16x8*)((st) + r * KS + tmap * 128 + d0 * 32 + hi * 16), k1 = *(const LAS bf16x8*)((st) + (32 + r) * KS + tmap * 128 + d0 * 32 + hi * 16); \
                a0 = MFMA32(k0, qf[d0], d0 == 0 ? negm : a0); a1 = MFMA32(k1, qf[d0], d0 == 0 ? negm : a1); } } while (0)
        LOAD_TILE1(0); STORE_TILE1(lds); LOAD_TILE1(1); STORE_TILE1(lds + STAGE); __syncthreads();
        f32x16 pc0, pc1;
        QK_TILE1(lds, pc0, pc1);
        int oc = 0, on = STAGE, ow = 2 * STAGE;
        for (int t = 0; t < 36; ++t) {
            if (t + 2 < 36) LOAD_TILE1(t + 2);
            f32x16 pn0, pn1;
            QK_TILE1(lds + on, pn0, pn1);
            bf16x8 pb[2][2];
            softmax_tile<4, true>(pc0, pc1, pn0, pn1, negm, m, l, o, pb, t == 0);
            SCHED_FENCE();
            s16x4 vA[2][2];
            pv_load<4, VS>(vA, lds + oc + 64 * KS, voff, 0);
            pv_rest<4, VS>(o, vA, pb, lds + oc + 64 * KS, voff);
            if (t + 2 < 36) STORE_TILE1(lds + ow);
            __syncthreads();
            pc0 = pn0; pc1 = pn1;
            const int tmpo = oc; oc = on; on = ow; ow = tmpo;
        }
#undef QK_TILE1
#undef TILE_ROW1
#undef LOAD_TILE1
#undef STORE_TILE1
        const float inv = (tmap ? lam : 1.f) / half_sum(l);
        if (tmap == 1) {
#pragma unroll
            for (int d0 = 0; d0 < 4; ++d0)
#pragma unroll
                for (int i2 = 0; i2 < 16; ++i2) xch[(sq * 64 + d0 * 16 + i2) * 64 + lane] = o[d0][i2] * inv;
        }
        __syncthreads();
        if (tmap == 0) {
            float ss = 0.f;
#pragma unroll
            for (int d0 = 0; d0 < 4; ++d0)
#pragma unroll
                for (int i2 = 0; i2 < 16; ++i2) { const float v = o[d0][i2] * inv - xch[(sq * 64 + d0 * 16 + i2) * 64 + lane]; o[d0][i2] = v; ss += v * v; }
            ss = half_sum(ss);
            const float rs = (1.f - LAM_INIT) / sqrtf(ss * (1.f / 128.f) + 1e-5f);
            bf16_t* op = AO + (size_t)(qrow0 + r) * DM + h * 128 + 4 * hi;
#pragma unroll
            for (int d0 = 0; d0 < 4; ++d0)
#pragma unroll
                for (int tq = 0; tq < 4; ++tq) { const f32x4 g = *(const f32x4*)(subg + d0 * 32 + 8 * tq + 4 * hi);
                    u32x2 w; w.x = pk2(o[d0][4 * tq] * rs * g.x, o[d0][4 * tq + 1] * rs * g.y); w.y = pk2(o[d0][4 * tq + 2] * rs * g.z, o[d0][4 * tq + 3] * rs * g.w);
                    *(u32x2*)(op + d0 * 32 + 8 * tq) = w; }
        }
        __syncthreads();
    }
    __builtin_amdgcn_s_setprio(0);
}
__global__ void __launch_bounds__(512) fwd_megakernel(Params P) {
    extern __shared__ __attribute__((aligned(16))) unsigned char lds_raw[];
    LAS unsigned char* lds = (LAS unsigned char*)lds_raw;
    cg::grid_group grid = cg::this_grid();
    unsigned char* ws = P.ws;
    float* mod = (float*)(ws + WS_MOD);
    float* XC = (float*)(ws + WS_XC);
    bf16_t* HB = (bf16_t*)(ws + WS_HB);
    bf16_t* Qb = (bf16_t*)(ws + WS_Q); bf16_t* Kb = (bf16_t*)(ws + WS_K); bf16_t* Vb = (bf16_t*)(ws + WS_V); bf16_t* AO = (bf16_t*)(ws + WS_AO);
    bf16_t* HM = (bf16_t*)(ws + WS_HMID);
    const int G = gridDim.x, bid = blockIdx.x;

    unsigned* barw = (unsigned*)(ws + WS_BAR);
    if (bid == 0) for (int i = threadIdx.x; i < XCD_BAR_WORDS; i += 512) barw[i] = 0u;
    if (threadIdx.x < 2) ((LAS unsigned*)(lds + LDS_BARST))[threadIdx.x] = 0u;
    phase_mods(P, lds);
    __syncthreads();
    phase_weights(P, lds);
    grid.sync();
    (void)xcd_barrier_post(barw, (volatile LAS unsigned*)(lds + LDS_BARST));
#define GRID_SYNC() do { XcdBarrier bar_; bar_.bar = (unsigned*)(P.ws + WS_BAR); bar_.x = xb_xcc_id(); bar_.st = (volatile LAS unsigned*)(lds + LDS_BARST); xcd_barrier(bar_); } while (0)
    row_phase<false>(MT, P.in[0], P.in[2], nullptr, nullptr, nullptr, nullptr, mod, 0, 1, HB);
    GRID_SYNC();

    for (int layer = 0; layer < 2; ++layer) {
        const int Mrows = layer == 0 ? MT : ML;
        const float* modl = mod + (size_t)layer * 17 * NMODC;
        {
            const int KW = layer == 0 ? 128 : DM;
            pg8::Gemm g{HB, (const bf16_t*)(ws + (layer == 0 ? WS_WQKV0 : WS_WQKV1)), MT, DM + 2 * KW, DM};
            pg8::StaticOrder S; S.init(g.M, g.N, G, bid);
            pg8::EpiQKV E{Qb, Kb, Vb, KW, 0.125f * LOG2E};
            pg8::gemm_phase<pg8::EpiQKV, pg8::StaticOrder, true, true>(lds, g, S, E);
        }
        GRID_SYNC();
        if (layer == 0) attn_window_phase(P, lds); else attn_diff_phase(P, lds);
        GRID_SYNC();
        {
            pg8::Gemm g{AO, (const bf16_t*)(ws + (layer == 0 ? WS_WO0 : WS_WO1)), Mrows, DM, DM};
            pg8::StaticOrder S; S.init(g.M, g.N, G, bid);
            pg8::EpiResid E{layer == 0 ? P.in[0] : P.out, layer == 0 ? P.in[2] : XC, P.out, XC, modl + 2 * DM};
            pg8::gemm_phase<pg8::EpiResid, pg8::StaticOrder, true, true>(lds, g, S, E);
        }
        GRID_SYNC();
        row_phase<true>(Mrows, P.out, XC, P.out, XC, P.in[6] + layer * DM, P.in[7] + layer * DM, modl, 3, 4, HB);
        GRID_SYNC();
        {
            pg8::Gemm g{HB, (const bf16_t*)(ws + (layer == 0 ? WS_W10 : WS_W11)), Mrows, FF, DM};
            pg8::StaticOrder S; S.init(g.M, g.N, G, bid);
            pg8::EpiRelu2 E{HM, FF};
            pg8::gemm_phase<pg8::EpiRelu2, pg8::StaticOrder, true, true>(lds, g, S, E);
        }
        GRID_SYNC();
        {
            pg8::Gemm g{HM, (const bf16_t*)(ws + (layer == 0 ? WS_W20 : WS_W21)), Mrows, DM, FF};
            pg8::StaticOrder S; S.init(g.M, g.N, G, bid);
            pg8::EpiResid E{P.out, XC, P.out, XC, modl + 5 * DM};
            pg8::gemm_phase<pg8::EpiResid, pg8::StaticOrder, true, true>(lds, g, S, E);
        }
        GRID_SYNC();
        row_phase<true>(Mrows, P.out, XC, P.out, XC, P.in[8] + layer * DM, P.in[9] + layer * DM, modl + 17 * NMODC, 0, 1, layer == 0 ? HB : nullptr);
        if (layer == 0) GRID_SYNC();
    }
}

extern "C" void kernel_launch(void* const* d_in, const int* in_sizes, int n_in, void* d_out, int out_size, void* d_ws, size_t ws_size, hipStream_t stream) {
    static int grid_blocks = 0;
    if (grid_blocks == 0) {
        if (n_in != 26 || out_size != ML * DM || ws_size < WS_END) { fprintf(stderr, "kernel_launch: unexpected shapes (n_in %d out %d ws %zu)\n", n_in, out_size, ws_size); grid_blocks = -1; return; }
        int dev = 0, cus = 0, per_cu = 0;
        hipGetDevice(&dev);
        hipDeviceGetAttribute(&cus, hipDeviceAttributeMultiprocessorCount, dev);
        hipFuncSetAttribute((const void*)fwd_megakernel, hipFuncAttributeMaxDynamicSharedMemorySize, LDS_BYTES);
        hipOccupancyMaxActiveBlocksPerMultiprocessor(&per_cu, (const void*)fwd_megakernel, 512, LDS_BYTES);
        if (per_cu < 1) { fprintf(stderr, "kernel_launch: occupancy query reports %d blocks per CU\n", per_cu); per_cu = 1; }
        grid_blocks = cus * per_cu;
        (void)hipGetLastError();
    }
    if (grid_blocks < 0) return;
    Params p{};
    for (int i = 0; i < 26; ++i) p.in[i] = (const float*)d_in[i];
    p.out = (float*)d_out; p.ws = (unsigned char*)d_ws;
    void* args[] = {&p};
    hipError_t e = hipLaunchCooperativeKernel((const void*)fwd_megakernel, dim3(grid_blocks), dim3(512), args, LDS_BYTES, stream);
    if (e != hipSuccess) fprintf(stderr, "cooperative launch failed: %s (grid %d)\n", hipGetErrorString(e), grid_blocks);
}
```

```cpp
#include <hip/hip_runtime.h>
#include <hip/hip_cooperative_groups.h>
#include <cstdio>
#include <cstdint>
namespace cg = cooperative_groups;

constexpr int NB = 16, SEQ = 2048, CTXL = 256, DM = 1024, FF = 4096;
constexpr int ML = NB * SEQ, MC = NB * CTXL, MT = ML + MC;
constexpr int NMODC = 6 * DM;
constexpr float LOG2E = 1.4426950408889634f;
constexpr float DN_ALPHA = 1.4142135623730951f;
constexpr float LAM_INIT = 0.35550906759096926f;

namespace pg8 {
#define PG8_LAS __attribute__((address_space(3)))
typedef unsigned short bf16_t;
typedef short bf16x8 __attribute__((ext_vector_type(8)));
typedef float f32x4 __attribute__((ext_vector_type(4)));
typedef unsigned u32x4 __attribute__((ext_vector_type(4)));
constexpr int BM = 256, BK = 64, HALF = 128, HTB = HALF * BK * 2  , STAGE_BYTES = 8 * HTB, NXCD = 8, WGM = 8;

__host__ __device__ __forceinline__ int lds_byte(int r, int c) { const int st = (r >> 4) * 2 + (c >> 5), rr = r & 15, cc = c & 31, ob = rr * 64 + cc * 2; return st * 1024 + (ob ^ (((ob >> 9) & 1) << 5)); }
__host__ __device__ __forceinline__ void stage_rc(int b, int& R, int& C) { const int st = b / 1024, sb = b % 1024, swz = sb ^ (((sb >> 9) & 1) << 5); R = (st >> 1) * 16 + swz / 64; C = (st & 1) * 32 + (swz % 64) / 2; }
__host__ __device__ __forceinline__ int perm32(int rho) { const int n = rho >> 4, i = rho & 15; return 8 * (i >> 2) + 4 * n + (i & 3); }

struct Unit { int pm, pn; };
struct Gemm { const bf16_t* A; const bf16_t* Bt; int M, N, K; };

struct StaticOrder {
    int nM, nN, nwg, G, c;
    __host__ __device__ void init(int M, int N, int G_, int c_) { nM = M / BM; nN = N / BM; nwg = nM * nN; G = G_; c = c_; }
    __host__ __device__ bool next(int i, Unit& u) const {
        const long L = (long)i * G + c; if (L >= nwg) return false;
        int wgid = (int)L; { const int q = nwg / NXCD, r = nwg % NXCD, xcd = wgid % NXCD, off = wgid / NXCD; wgid = (xcd < r ? xcd * (q + 1) : r * (q + 1) + (xcd - r) * q) + off; }
        const int nig = WGM * nN, gid = wgid / nig, fm = gid * WGM, gsz = (nM - fm) < WGM ? (nM - fm) : WGM;
        u.pm = fm + ((wgid % nig) % gsz); u.pn = (wgid % nig) / gsz; return true;
    }
    __device__ __forceinline__ void a_ready(const Unit&) const {}
    __device__ __forceinline__ void done(const Unit&) const {}
};

__device__ __forceinline__ unsigned cvt_pk_bf16(float lo, float hi) { unsigned r; asm volatile("v_cvt_pk_bf16_f32 %0, %1, %2" : "=v"(r) : "v"(lo), "v"(hi)); return r; }
typedef float f32x2 __attribute__((ext_vector_type(2)));
typedef unsigned u32x2 __attribute__((ext_vector_type(2)));
struct EpiQKV {
    static constexpr bool PERM = true, AFTER_DRAIN = false;
    bf16_t *Q, *Kb, *Vb; int KW; float qscale;
    __device__ __forceinline__ void operator()(const f32x4 (&acc)[2][2][4][2], const Unit& u, int wr, int wc, int fr, int fq) const {
        const int row0 = u.pm * BM + wr * 64 + fr;
        const bool latent = (u.pm * BM) < ML;
        float invf[4];
#pragma unroll
        for (int e = 0; e < 4; ++e) invf[e] = __builtin_amdgcn_exp2f(-(float)(4 * fq + e) * (13.287712379549449f / 16.0f));
#pragma unroll
        for (int bj = 0; bj < 2; ++bj) {
            const int ctile = u.pn * BM + bj * HALF;
            bf16_t* dst; int ld, cbase; bool rope; float sc;
            if (ctile < DM) { dst = Q; ld = DM; cbase = ctile; rope = true; sc = qscale; }
            else if (ctile < DM + KW) { dst = Kb; ld = KW; cbase = ctile - DM; rope = true; sc = 1.f; }
            else { dst = Vb; ld = KW; cbase = ctile - DM - KW; rope = false; sc = 1.f; }
            rope = rope && latent;
            const int col0 = cbase + wc * 32 + 8 * fq;
#pragma unroll
            for (int ai = 0; ai < 2; ++ai)
#pragma unroll
                for (int m = 0; m < 4; ++m) {
                    const int row = row0 + ai * HALF + m * 16;
                    f32x4 v0 = acc[ai][bj][m][0], v1 = acc[ai][bj][m][1];
                    if (rope) {
                        const int t = row & (SEQ - 1);
                        const float pos = (float)((wc & 1) ? (t & 63) : (t >> 6));
                        f32x4 o0, o1;
#pragma unroll
                        for (int e = 0; e < 4; ++e) { const float ang = pos * invf[e]; const float cs = __cosf(ang), sn = __sinf(ang);
                            o0[e] = v0[e] * cs - v1[e] * sn; o1[e] = v0[e] * sn + v1[e] * cs; }
                        v0 = o0; v1 = o1;
                    }
                    v0 = v0 * sc; v1 = v1 * sc;
                    u32x4 w; w.x = cvt_pk_bf16(v0[0], v0[1]); w.y = cvt_pk_bf16(v0[2], v0[3]); w.z = cvt_pk_bf16(v1[0], v1[1]); w.w = cvt_pk_bf16(v1[2], v1[3]);
                    *(u32x4*)(dst + (size_t)row * ld + col0) = w;
                }
        }
    }
};
struct EpiRelu2 {
    static constexpr bool PERM = true, AFTER_DRAIN = false;
    bf16_t* O; int ldc;
    __device__ __forceinline__ void operator()(const f32x4 (&acc)[2][2][4][2], const Unit& u, int wr, int wc, int fr, int fq) const {
        const int row0 = u.pm * BM + wr * 64 + fr, col0 = u.pn * BM + wc * 32 + 8 * fq;
#pragma unroll
        for (int ai = 0; ai < 2; ++ai)
#pragma unroll
            for (int m = 0; m < 4; ++m) { bf16_t* rowp = O + (size_t)(row0 + ai * HALF + m * 16) * ldc + col0;
#pragma unroll
                for (int bj = 0; bj < 2; ++bj) { f32x4 v0 = acc[ai][bj][m][0], v1 = acc[ai][bj][m][1];
#pragma unroll
                    for (int e = 0; e < 4; ++e) { const float a = fmaxf(v0[e], 0.f), b = fmaxf(v1[e], 0.f); v0[e] = a * a; v1[e] = b * b; }
                    u32x4 w; w.x = cvt_pk_bf16(v0[0], v0[1]); w.y = cvt_pk_bf16(v0[2], v0[3]); w.z = cvt_pk_bf16(v1[0], v1[1]); w.w = cvt_pk_bf16(v1[2], v1[3]);
                    *(u32x4*)(rowp + bj * HALF) = w; } }
    }
};
struct EpiResid {
    static constexpr bool PERM = false, AFTER_DRAIN = false;
    const float *xl, *xc; float *yl, *yc; const float* gate;
    int row_base;
    __device__ __forceinline__ void operator()(const f32x4 (&acc)[2][2][4][2], const Unit& u, int wr, int wc, int fr, int fq) const {
        const int prow = u.pm * BM + row_base;
        const bool latent = prow < ML;
        const float* xin = latent ? xl + (size_t)prow * DM : xc + (size_t)(prow - ML) * DM;
        float* yout = latent ? yl + (size_t)prow * DM : yc + (size_t)(prow - ML) * DM;
        const float* gp = gate + (size_t)(latent ? (prow >> 11) : 16) * NMODC;
        const int col0 = u.pn * BM + wc * 32 + 4 * fq;
        f32x4 gv[2][2];
#pragma unroll
        for (int bj = 0; bj < 2; ++bj)
#pragma unroll
            for (int n = 0; n < 2; ++n) gv[bj][n] = *(const f32x4*)(gp + col0 + bj * HALF + n * 16);
#pragma unroll
        for (int ai = 0; ai < 2; ++ai)
#pragma unroll
            for (int m = 0; m < 4; ++m) { const size_t off = (size_t)(wr * 64 + fr + ai * HALF + m * 16) * DM + col0;
#pragma unroll
                for (int bj = 0; bj < 2; ++bj)
#pragma unroll
                    for (int n = 0; n < 2; ++n) { const f32x4 xv = *(const f32x4*)(xin + off + bj * HALF + n * 16);
                        *(f32x4*)(yout + off + bj * HALF + n * 16) = xv * DN_ALPHA + gv[bj][n] * acc[ai][bj][m][n]; } }
    }
};


template <class Epi, class Sched, bool ALIGN_EPI = false, bool SP2 = false>
__device__ __forceinline__ void gemm_phase(PG8_LAS unsigned char* lds, const Gemm g, const Sched& S, const Epi& E) {
    int tid_ = threadIdx.x; asm volatile("" : "+v"(tid_));
    const int tid = tid_, wid = __builtin_amdgcn_readfirstlane(tid >> 6), lane = tid & 63, wr = wid >> 2, wc = wid & 3, fr = lane & 15, fq = lane >> 4;
    const int K = g.K, nt = K / BK;
    unsigned voffA[2], voffB[2];
#pragma unroll
    for (int i = 0; i < 2; ++i) { int R, C; stage_rc(tid * 16 + i * 8192, R, C); const int Rb = Epi::PERM ? ((R & ~31) + perm32(R & 31)) : R;
        voffA[i] = (unsigned)(R * K + C) * 2u; voffB[i] = (unsigned)(Rb * K + C) * 2u; }
    const size_t kstep = (size_t)(BK * 2);
    const size_t hstep = (size_t)HALF * K * 2;
    const size_t tstep = 2 * hstep;
    const unsigned ldsw = (unsigned)wid * 1024u;
    const int aoff = lds_byte(wr * 64 + fr, fq * 8), boff = lds_byte(wc * 32 + fr, fq * 8);
#define PG8_SA(b, h) (((b) * 2 + (h)) * HTB)
#define PG8_SB(b, h) ((4 + (b) * 2 + (h)) * HTB)
#define PG8_STAGE(bufoff, gbase, voff) do { _Pragma("unroll") for (int _i = 0; _i < 2; ++_i) \
        __builtin_amdgcn_global_load_lds((const unsigned*)((const char*)(gbase) + (voff)[_i]), (PG8_LAS unsigned*)(lds + (bufoff) + ldsw + _i * 8192), 16, 0, 0); } while (0)
#define PG8_LDA(dst, b, h) do { _Pragma("unroll") for (int m = 0; m < 4; ++m) _Pragma("unroll") for (int k = 0; k < 2; ++k) dst[m][k] = *(const PG8_LAS bf16x8*)(lds + PG8_SA(b, h) + aoff + m * 2048 + k * 1024); } while (0)
#define PG8_LDB(dst, b, h) do { _Pragma("unroll") for (int n = 0; n < 2; ++n) _Pragma("unroll") for (int k = 0; k < 2; ++k) dst[n][k] = *(const PG8_LAS bf16x8*)(lds + PG8_SB(b, h) + boff + n * 2048 + k * 1024); } while (0)
#define PG8_MMA(ai, bj, At, Bt) do { __builtin_amdgcn_s_setprio(1); _Pragma("unroll") for (int m = 0; m < 4; ++m) _Pragma("unroll") for (int n = 0; n < 2; ++n) _Pragma("unroll") for (int k = 0; k < 2; ++k) \
        acc[ai][bj][m][n] = __builtin_amdgcn_mfma_f32_16x16x32_bf16(Bt[n][k], At[m][k], acc[ai][bj][m][n], 0, 0, 0); __builtin_amdgcn_s_setprio(0); } while (0)
#define PG8_WAIT_V(n) asm volatile("s_waitcnt vmcnt(" #n ")" ::: "memory")
#define PG8_WAIT_L(n) asm volatile("s_waitcnt lgkmcnt(" #n ")" ::: "memory")
#define PG8_BAR __builtin_amdgcn_s_barrier()
#define PG8_SCHED __builtin_amdgcn_sched_barrier(0)
    Unit cur, nxt; int ui = 0;
    if (!S.next(0, cur)) return;
    f32x4 acc[2][2][4][2];
#pragma unroll
    for (int a = 0; a < 2; ++a)
#pragma unroll
        for (int b = 0; b < 2; ++b)
#pragma unroll
            for (int m = 0; m < 4; ++m)
#pragma unroll
                for (int n = 0; n < 2; ++n) acc[a][b][m][n] = (f32x4){0.f, 0.f, 0.f, 0.f};
    bf16x8 At[4][2], B0[2][2], B1[2][2];
    const char* cA = (const char*)g.A + (size_t)cur.pm * tstep; const char* cB = (const char*)g.Bt + (size_t)cur.pn * tstep;
    S.a_ready(cur);
    if constexpr (SP2) {
        PG8_STAGE(PG8_SB(0, 0), cB, voffB); PG8_STAGE(PG8_SB(0, 1), cB + hstep, voffB); PG8_STAGE(PG8_SA(0, 0), cA, voffA); PG8_STAGE(PG8_SA(0, 1), cA + hstep, voffA);
        if (wr == 1) PG8_BAR;
        PG8_WAIT_V(2); PG8_BAR;
        PG8_STAGE(PG8_SB(1, 0), cB + kstep, voffB); PG8_STAGE(PG8_SA(1, 0), cA + kstep, voffA); PG8_STAGE(PG8_SB(1, 1), cB + hstep + kstep, voffB);
        PG8_WAIT_V(6); PG8_BAR;
    } else {
        PG8_STAGE(PG8_SB(0, 0), cB, voffB); PG8_STAGE(PG8_SA(0, 0), cA, voffA); PG8_STAGE(PG8_SB(0, 1), cB + hstep, voffB); PG8_STAGE(PG8_SA(0, 1), cA + hstep, voffA);
        if (wr == 1) PG8_BAR;
        PG8_WAIT_V(4); PG8_BAR;
        PG8_STAGE(PG8_SB(1, 0), cB + kstep, voffB); PG8_STAGE(PG8_SA(1, 0), cA + kstep, voffA); PG8_STAGE(PG8_SB(1, 1), cB + hstep + kstep, voffB);
        PG8_WAIT_V(6); PG8_BAR;
    }
    for (;;) {
        const bool has_next = S.next(ui + 1, nxt);
        const char* nA = has_next ? (const char*)g.A + (size_t)nxt.pm * tstep : cA; const char* nB = has_next ? (const char*)g.Bt + (size_t)nxt.pn * tstep : cB;
        for (int t = 0; t < nt; t += 2) {
            const bool last = (t == nt - 2);
            const char* a1 = cA + (size_t)(t + 1) * kstep;
            const char* a2 = last ? nA : cA + (size_t)(t + 2) * kstep; const char* b2 = last ? nB : cB + (size_t)(t + 2) * kstep;
            const char* a3 = a2 + kstep; const char* b3 = b2 + kstep;
            if (last && has_next) S.a_ready(nxt);
            if constexpr (SP2) {
            PG8_LDB(B0, 0, 0); PG8_LDB(B1, 0, 1); PG8_SCHED; PG8_LDA(At, 0, 0); PG8_STAGE(PG8_SA(1, 1), a1 + hstep, voffA);
            PG8_WAIT_V(8); PG8_WAIT_L(0); PG8_BAR; PG8_MMA(0, 0, At, B0); PG8_MMA(0, 1, At, B1); PG8_BAR; PG8_SCHED;
            PG8_LDA(At, 0, 1); PG8_STAGE(PG8_SB(0, 0), b2, voffB); PG8_STAGE(PG8_SB(0, 1), b2 + hstep, voffB); PG8_STAGE(PG8_SA(0, 0), a2, voffA);
            PG8_WAIT_V(8); PG8_WAIT_L(0); PG8_BAR; PG8_MMA(1, 0, At, B0); PG8_MMA(1, 1, At, B1); PG8_BAR; PG8_SCHED;
            PG8_LDB(B0, 1, 0); PG8_LDB(B1, 1, 1); PG8_SCHED; PG8_LDA(At, 1, 0); PG8_STAGE(PG8_SA(0, 1), a2 + hstep, voffA);
            PG8_WAIT_V(8); PG8_WAIT_L(0); PG8_BAR; PG8_MMA(0, 0, At, B0); PG8_MMA(0, 1, At, B1); PG8_BAR; PG8_SCHED;
            PG8_LDA(At, 1, 1); PG8_STAGE(PG8_SB(1, 0), b3, voffB); PG8_STAGE(PG8_SB(1, 1), b3 + hstep, voffB); PG8_STAGE(PG8_SA(1, 0), a3, voffA);
            PG8_WAIT_V(8); PG8_WAIT_L(0); PG8_BAR; PG8_MMA(1, 0, At, B0); PG8_MMA(1, 1, At, B1); PG8_BAR; PG8_SCHED;
            } else {
            PG8_LDB(B0, 0, 0); PG8_SCHED; PG8_LDA(At, 0, 0); PG8_STAGE(PG8_SA(1, 1), a1 + hstep, voffA);
            PG8_WAIT_L(8); PG8_BAR; PG8_WAIT_L(0); PG8_MMA(0, 0, At, B0); PG8_BAR; PG8_SCHED;
            PG8_LDB(B1, 0, 1); PG8_STAGE(PG8_SB(0, 0), b2, voffB);
            PG8_BAR; PG8_WAIT_L(0); PG8_MMA(0, 1, At, B1); PG8_BAR;
            PG8_LDA(At, 0, 1); PG8_STAGE(PG8_SA(0, 0), a2, voffA);
            PG8_BAR; PG8_WAIT_L(0); PG8_MMA(1, 0, At, B0); PG8_BAR; PG8_SCHED;
            PG8_STAGE(PG8_SB(0, 1), b2 + hstep, voffB);
            PG8_WAIT_V(6); PG8_BAR; PG8_MMA(1, 1, At, B1); PG8_BAR;
            PG8_LDB(B0, 1, 0); PG8_SCHED; PG8_LDA(At, 1, 0); PG8_STAGE(PG8_SA(0, 1), a2 + hstep, voffA);
            PG8_WAIT_L(8); PG8_BAR; PG8_WAIT_L(0); PG8_MMA(0, 0, At, B0); PG8_BAR; PG8_SCHED;
            PG8_LDB(B1, 1, 1); PG8_STAGE(PG8_SB(1, 0), b3, voffB);
            PG8_BAR; PG8_WAIT_L(0); PG8_MMA(0, 1, At, B1); PG8_BAR;
            PG8_LDA(At, 1, 1); PG8_STAGE(PG8_SA(1, 0), a3, voffA);
            PG8_BAR; PG8_WAIT_L(0); PG8_MMA(1, 0, At, B0); PG8_BAR; PG8_SCHED;
            PG8_STAGE(PG8_SB(1, 1), b3 + hstep, voffB);
            PG8_WAIT_V(6); PG8_BAR; PG8_MMA(1, 1, At, B1); PG8_BAR;
            }
        }
        if constexpr (ALIGN_EPI) { if (wr == 0) PG8_BAR; }
        if constexpr (!Epi::AFTER_DRAIN) { E(acc, cur, wr, wc, fr, fq); S.done(cur); }
        if (!has_next) break;
#pragma unroll
        for (int a = 0; a < 2; ++a)
#pragma unroll
            for (int b = 0; b < 2; ++b)
#pragma unroll
                for (int m = 0; m < 4; ++m)
#pragma unroll
                    for (int n = 0; n < 2; ++n) acc[a][b][m][n] = (f32x4){0.f, 0.f, 0.f, 0.f};
        cur = nxt; cA = nA; cB = nB; ++ui;
        if constexpr (ALIGN_EPI) { if (wr == 1) PG8_BAR; }
    }
    PG8_WAIT_V(0);
    if constexpr (!ALIGN_EPI) { if (wr == 0) PG8_BAR; }
    PG8_BAR;
    if constexpr (Epi::AFTER_DRAIN) { E.fused(acc, cur, wr, wc, fr, fq, lds, wid, lane); S.done(cur); }
#undef PG8_SA
#undef PG8_SB
#undef PG8_STAGE
#undef PG8_LDA
#undef PG8_LDB
#undef PG8_MMA
#undef PG8_WAIT_V
#undef PG8_WAIT_L
#undef PG8_BAR
#undef PG8_SCHED
}
}
#define LAS __attribute__((address_space(3)))
typedef unsigned short bf16_t;
typedef short bf16x8 __attribute__((ext_vector_type(8)));
typedef short s16x4 __attribute__((ext_vector_type(4)));
typedef float f32x4 __attribute__((ext_vector_type(4)));
typedef float f32x16 __attribute__((ext_vector_type(16)));
typedef unsigned u32x4 __attribute__((ext_vector_type(4)));
typedef unsigned u32x2 __attribute__((ext_vector_type(2)));
typedef float f32x2_t __attribute__((ext_vector_type(2)));
typedef __bf16 bf16x2_t __attribute__((ext_vector_type(2)));

constexpr size_t MiB = 1u << 20;
constexpr size_t WS_MISC = 0, WS_MOD = 1 * MiB;
constexpr size_t WS_WQKV0 = 2 * MiB, WS_WO0 = 5 * MiB, WS_W10 = 8 * MiB, WS_W20 = 16 * MiB;
constexpr size_t WS_WQKV1 = 24 * MiB, WS_WO1 = 30 * MiB, WS_W11 = 32 * MiB, WS_W21 = 40 * MiB;
constexpr size_t WS_XC = 48 * MiB;
constexpr size_t WS_HB = 64 * MiB;
constexpr size_t WS_Q = 136 * MiB, WS_K = 208 * MiB, WS_V = 280 * MiB, WS_AO = 352 * MiB;
constexpr size_t WS_HMID = 136 * MiB;
constexpr size_t WS_END = 424 * MiB;
constexpr int LDS_BYTES = 147456;

struct Params { const float* in[26]; float* out; unsigned char* ws; };
constexpr size_t WS_BAR = 65536;
constexpr int LDS_BARST = 131072 + 64;
#define XB_TMO      128
#define XB_XCNT(j)  (256  + 64 * (j))
#define XB_XSUB(j)  (1280 + 64 * (j))
#define XB_XGEN(j)  (2304 + 64 * (j))
#define XB_TOP      3328
#define XB_TOPGEN   3392
#define XCD_BAR_WORDS 3456
#define XB_SPIN_CAP (1u << 18)

__device__ __forceinline__ unsigned xb_ld(unsigned* p)              { return __hip_atomic_load(p, __ATOMIC_RELAXED, __HIP_MEMORY_SCOPE_AGENT); }
__device__ __forceinline__ unsigned xb_add(unsigned* p, unsigned v) { return __hip_atomic_fetch_add(p, v, __ATOMIC_RELAXED, __HIP_MEMORY_SCOPE_AGENT); }
__device__ __forceinline__ unsigned xb_xcc_id() { return (unsigned)__builtin_amdgcn_s_getreg((3 << 11) | 20) & 0xFu; }
#define XB_SPIN(cond, bar) do { unsigned _sp = 0; while (cond) { __builtin_amdgcn_s_sleep(1); \
    if ((++_sp & 255u) == 0u) { if (xb_ld(&(bar)[XB_TMO])) break; if (_sp > XB_SPIN_CAP) { atomicAdd(&(bar)[XB_TMO], 1u); break; } } } } while (0)

struct XcdBarrier {
    unsigned* bar; unsigned x;
    volatile LAS unsigned* st;
};

__device__ __forceinline__ XcdBarrier xcd_barrier_post(unsigned* bar, volatile LAS unsigned* st) {
    XcdBarrier b; b.bar = bar; b.x = xb_xcc_id(); b.st = st;
    if (threadIdx.x == 0) (void)xb_add(&bar[XB_XCNT(b.x)], 1u);
    return b;
}
__device__ __forceinline__ void xcd_barrier_complete(unsigned* bar, unsigned x, unsigned& nloc, unsigned& nx) {
    const unsigned G = gridDim.x * gridDim.y * gridDim.z;
    unsigned sum, cnt, mine, sp = 0u;
    for (;;) {
        sum = 0u; cnt = 0u; mine = 0u;
#pragma unroll
        for (unsigned j = 0; j < 16; ++j) { const unsigned c = xb_ld(&bar[XB_XCNT(j)]); sum += c; cnt += (c > 0u) ? 1u : 0u; mine = (j == x) ? c : mine; }
        if (sum == G) break;
        __builtin_amdgcn_s_sleep(1);
        if ((++sp & 255u) == 0u) { if (xb_ld(&bar[XB_TMO])) break; if (sp > XB_SPIN_CAP) { atomicAdd(&bar[XB_TMO], 1u); break; } }
    }
    nloc = mine > 0u ? mine : 1u; nx = cnt > 0u ? cnt : 1u;
}

__device__ __forceinline__ void xcd_barrier(const XcdBarrier& b) {
    asm volatile("s_waitcnt vmcnt(0)" ::: "memory");
    __syncthreads();
    if (threadIdx.x == 0) {
        unsigned* bar = b.bar;
        __builtin_amdgcn_s_waitcnt(0);
        unsigned nloc = b.st[0], nx = b.st[1];
        if (nloc == 0u) { xcd_barrier_complete(bar, b.x, nloc, nx); b.st[0] = nloc; b.st[1] = nx; }
        const unsigned old = xb_add(&bar[XB_XSUB(b.x)], 1u);
        const unsigned gen = old / nloc;
        if (old + 1u == (gen + 1u) * nloc) {
            __builtin_amdgcn_fence(__ATOMIC_RELEASE, "agent");
            asm volatile("s_waitcnt vmcnt(0)" ::: "memory");
            const unsigned og = xb_add(&bar[XB_TOP], 1u);
            const unsigned tg = og / nx;
            if (og + 1u == (tg + 1u) * nx) xb_add(&bar[XB_TOPGEN], 1u);
            else XB_SPIN(xb_ld(&bar[XB_TOPGEN]) == tg, bar);
            __builtin_amdgcn_fence(__ATOMIC_ACQUIRE, "agent");
            xb_add(&bar[XB_XGEN(b.x)], 1u);
            asm volatile("s_waitcnt vmcnt(0)" ::: "memory");
        } else {
            XB_SPIN(xb_ld(&bar[XB_XGEN(b.x)]) == gen, bar);
            __builtin_amdgcn_fence(__ATOMIC_ACQUIRE, "agent");
            asm volatile("s_waitcnt vmcnt(0)" ::: "memory");
        }
    }
    __syncthreads();
}


__device__ __forceinline__ unsigned pk2(float lo, float hi) { f32x2_t v = {lo, hi}; bf16x2_t b = __builtin_convertvector(v, bf16x2_t); return __builtin_bit_cast(unsigned, b); }
__device__ __forceinline__ float wave_sum(float v) {
#pragma unroll
    for (int o = 1; o < 64; o <<= 1) v += __shfl_xor(v, o);
    return v;
}
__device__ __forceinline__ float half_max(float m) { auto rr = __builtin_amdgcn_permlane32_swap(__float_as_uint(m), __float_as_uint(m), false, false); return fmaxf(__uint_as_float(rr[0]), __uint_as_float(rr[1])); }
__device__ __forceinline__ float half_sum(float m) { auto rr = __builtin_amdgcn_permlane32_swap(__float_as_uint(m), __float_as_uint(m), false, false); return __uint_as_float(rr[0]) + __uint_as_float(rr[1]); }
__device__ __forceinline__ s16x4 vtr(LAS const unsigned char* p) { typedef short v4i16_t __attribute__((ext_vector_type(4))); return __builtin_bit_cast(s16x4, __builtin_amdgcn_ds_read_tr16_b64_v4i16((LAS v4i16_t*)p)); }

__device__ __forceinline__ void phase_mods(const Params& P, LAS unsigned char* lds) {
    int tid_ = threadIdx.x; asm volatile("" : "+v"(tid_));
    const int tid = tid_, lane = tid & 63, wave = __builtin_amdgcn_readfirstlane(tid >> 6);
    float* mod = (float*)(P.ws + WS_MOD);
    if (blockIdx.x == gridDim.x - 1 && tid == 0) {
        float s1 = 0.f, s2 = 0.f;
        for (int i = 0; i < 64; ++i) { s1 += P.in[19][i] * P.in[20][i]; s2 += P.in[21][i] * P.in[22][i]; }
        ((float*)(P.ws + WS_MISC))[0] = __expf(s1) - __expf(s2) + LAM_INIT;
    }
    if (blockIdx.x >= 192) return;
    LAS float* S = (LAS float*)lds;
    LAS float* red = (LAS float*)(lds + 17 * 1024 * 4);
    for (int i = tid; i < 17 * 1024; i += 512) { const int r = i >> 10, k = i & 1023; const float v = r < 16 ? P.in[1][r * 1024 + k] : P.in[3][k]; S[i] = v / (1.f + __expf(-v)); }
    __syncthreads();
    for (int u = blockIdx.x; u < 192; u += gridDim.x) {
        const int l = u / 96, g = u % 96, n = g * 64 + lane;
        const float* W = P.in[4] + (size_t)l * DM * NMODC + n;
        float acc[17];
#pragma unroll
        for (int r = 0; r < 17; ++r) acc[r] = 0.f;
        const int k0 = wave * 128;
#pragma unroll 2
        for (int k = k0; k < k0 + 128; k += 4) {
            const float w0 = W[(size_t)k * NMODC], w1 = W[(size_t)(k + 1) * NMODC], w2 = W[(size_t)(k + 2) * NMODC], w3 = W[(size_t)(k + 3) * NMODC];
#pragma unroll
            for (int r = 0; r < 17; ++r) { const f32x4 s = *(const LAS f32x4*)(S + r * 1024 + k); acc[r] += (w0 * s.x + w1 * s.y) + (w2 * s.z + w3 * s.w); }
        }
#pragma unroll
        for (int r = 0; r < 17; ++r) red[(wave * 17 + r) * 64 + lane] = acc[r];
        __syncthreads();
        for (int idx = tid; idx < 17 * 64; idx += 512) { const int r = idx >> 6, ln = idx & 63; float s = 0.f;
#pragma unroll
            for (int w = 0; w < 8; ++w) s += red[(w * 17 + r) * 64 + ln];
            const int nn = g * 64 + ln; mod[(size_t)(l * 17 + r) * NMODC + nn] = s + P.in[5][l * NMODC + nn]; }
        __syncthreads();
    }
}
__device__ __forceinline__ unsigned f2bf(float f) { unsigned u = __builtin_bit_cast(unsigned, f); return (u + 0x7fffu + ((u >> 16) & 1u)) >> 16; }
__device__ __forceinline__ unsigned pk2i(float lo, float hi) { return f2bf(lo) | (f2bf(hi) << 16); }
__device__ __forceinline__ void transpose_item(const float* W, int K, int N, bf16_t* WT, int row_off, bool perm, LAS float* scr, int item, int lane) {
    const int nblk = N / 32, kb = item / nblk, nb = item % nblk, k0 = 64 * kb, n0 = 32 * nb;
    int sp = n0 + (lane & 31);
    if (perm) { const int p = sp & 63; sp = (sp & ~63) + 16 * (p >> 5) + 4 * ((p >> 3) & 3) + (p & 3) + 32 * ((p >> 2) & 1); }
#pragma unroll 8
    for (int i = 0; i < 32; ++i) { const int kk = 2 * i + (lane >> 5); scr[kk * 33 + (lane & 31)] = W[(size_t)(k0 + kk) * N + sp]; }
    asm volatile("s_waitcnt lgkmcnt(0)" ::: "memory");
    const int c = lane & 7;
#pragma unroll
    for (int j = 0; j < 4; ++j) { const int n = (lane >> 3) + 8 * j; const LAS float* s = scr + (8 * c) * 33 + n;
        u32x4 o; o.x = pk2i(s[0 * 33], s[1 * 33]); o.y = pk2i(s[2 * 33], s[3 * 33]); o.z = pk2i(s[4 * 33], s[5 * 33]); o.w = pk2i(s[6 * 33], s[7 * 33]);
        *(u32x4*)(WT + (size_t)(row_off + n0 + n) * K + k0 + 8 * c) = o; }
    asm volatile("s_waitcnt lgkmcnt(0)" ::: "memory");
}
__device__ __forceinline__ void phase_weights(const Params& P, LAS unsigned char* lds) {
    int tid_ = threadIdx.x; asm volatile("" : "+v"(tid_));
    const int lane = tid_ & 63, wave = __builtin_amdgcn_readfirstlane(tid_ >> 6);
    LAS float* scr = (LAS float*)(lds + wave * 16384);
    const int gw = blockIdx.x * 8 + wave, NGW = gridDim.x * 8;
    unsigned char* ws = P.ws;
    constexpr int I_DD = 16 * 32, I_DK0 = 16 * 4, I_1 = 16 * 128, I_2 = 64 * 32;
    constexpr int NITEMS = (I_DD + 2 * I_DK0 + I_DD + I_1 + I_2) + (4 * I_DD + I_1 + I_2);
    for (int it = gw; it < NITEMS; it += NGW) {
        int r = it;
#define TR_ITEM(cnt, W, K, N, WT, roff, perm) if (r < (cnt)) { transpose_item((W), (K), (N), (bf16_t*)(ws + (WT)), (roff), (perm), scr, r, lane); continue; } r -= (cnt);
        TR_ITEM(I_DD,  P.in[10], DM, DM,  WS_WQKV0, 0, true)
        TR_ITEM(I_DK0, P.in[11], DM, 128, WS_WQKV0, DM, true)
        TR_ITEM(I_DK0, P.in[12], DM, 128, WS_WQKV0, DM + 128, false)
        TR_ITEM(I_DD,  P.in[13], DM, DM,  WS_WO0, 0, false)
        TR_ITEM(I_1,   P.in[24], DM, FF,  WS_W10, 0, false)
        TR_ITEM(I_2,   P.in[25], FF, DM,  WS_W20, 0, false)
        TR_ITEM(I_DD,  P.in[15], DM, DM,  WS_WQKV1, 0, true)
        TR_ITEM(I_DD,  P.in[16], DM, DM,  WS_WQKV1, DM, true)
        TR_ITEM(I_DD,  P.in[17], DM, DM,  WS_WQKV1, 2 * DM, false)
        TR_ITEM(I_DD,  P.in[18], DM, DM,  WS_WO1, 0, false)
        TR_ITEM(I_1,   P.in[24] + (size_t)DM * FF, DM, FF, WS_W11, 0, false)
        TR_ITEM(I_2,   P.in[25] + (size_t)FF * DM, FF, DM, WS_W21, 0, false)
#undef TR_ITEM
    }
}
template <bool DO_LN>
__device__ __forceinline__ void row_phase(int row_lo, int nrows, int blk_lo, int nblk, const float* srcL, const float* srcC, float* dstL, float* dstC, const float* lng, const float* lnb,
                                          const float* modl  , int sh_chunk, int sc_chunk, bf16_t* HB) {
    int tid_ = threadIdx.x; asm volatile("" : "+v"(tid_));
    const int lane = tid_ & 63, wave = __builtin_amdgcn_readfirstlane(tid_ >> 6);
    const int gw = ((int)blockIdx.x - blk_lo) * 8 + wave, NGW = nblk * 8;
    if (gw < 0 || gw >= NGW) return;
    for (int row = row_lo + gw; row < nrows; row += NGW) {
        const bool latent = row < ML;
        const size_t roff = latent ? (size_t)row * DM : (size_t)(row - ML) * DM;
        const f32x4* xr = (const f32x4*)((latent ? srcL : srcC) + roff) + lane;
        f32x4 v[4];
#pragma unroll
        for (int j = 0; j < 4; ++j) v[j] = xr[64 * j];
        if (DO_LN) {
            float s = 0.f;
#pragma unroll
            for (int j = 0; j < 4; ++j) s += (v[j].x + v[j].y) + (v[j].z + v[j].w);
            const float mean = wave_sum(s) * (1.f / DM); float s2 = 0.f;
#pragma unroll
            for (int j = 0; j < 4; ++j) { v[j] = v[j] - mean; s2 += (v[j].x * v[j].x + v[j].y * v[j].y) + (v[j].z * v[j].z + v[j].w * v[j].w); }
            const float rstd = 1.f / sqrtf(wave_sum(s2) * (1.f / DM) + 1e-5f);
            f32x4* yr = (f32x4*)((latent ? dstL : dstC) + roff) + lane;
#pragma unroll
            for (int j = 0; j < 4; ++j) { const f32x4 g = ((const f32x4*)lng)[lane + 64 * j], b = ((const f32x4*)lnb)[lane + 64 * j]; v[j] = v[j] * rstd * g + b; yr[64 * j] = v[j]; }
        }
        if (HB) {
            const float* mrow = modl + (size_t)(latent ? (row >> 11) : 16) * NMODC;
            u32x2* hr = (u32x2*)(HB + (size_t)row * DM) + lane;
#pragma unroll
            for (int j = 0; j < 4; ++j) { const f32x4 sh = ((const f32x4*)(mrow + sh_chunk * DM))[lane + 64 * j], sc = ((const f32x4*)(mrow + sc_chunk * DM))[lane + 64 * j];
                const f32x4 h = v[j] * (sc + 1.0f) + sh; u32x2 w; w.x = pk2(h.x, h.y); w.y = pk2(h.z, h.w); hr[64 * j] = w; }
        }
    }
}
#define MFMA32(a, b, c) __builtin_amdgcn_mfma_f32_32x32x16_bf16((a), (b), (c), 0, 0, 0)
__device__ __forceinline__ float max3f(float a, float b, float c) { float r; asm("v_max3_f32 %0, %1, %2, %3" : "=v"(r) : "v"(a), "v"(b), "v"(c)); return r; }
__device__ __forceinline__ float max2f(float a, float b) { float r; asm("v_max_f32_e32 %0, %1, %2" : "=v"(r) : "v"(a), "v"(b)); return r; }
__device__ __forceinline__ float half_max2(float m) { auto rr = __builtin_amdgcn_permlane32_swap(__float_as_uint(m), __float_as_uint(m), false, false); return max2f(__uint_as_float(rr[0]), __uint_as_float(rr[1])); }
template <int ND, bool NEXT>
__device__ __forceinline__ void softmax_tile(f32x16& p0, f32x16& p1, f32x16& n0, f32x16& n1, f32x16& negm, float& m, float& l, f32x16 (&o)[ND], bf16x8 (&pb)[2][2], bool first) {
    float a = max3f(p0[0], p0[1], p1[0]), b = max3f(p0[2], p0[3], p1[1]); a = max3f(a, p1[2], p1[3]);
#pragma unroll
    for (int i = 4; i < 16; i += 4) { a = max3f(a, p0[i], p0[i + 1]); b = max3f(b, p0[i + 2], p0[i + 3]); a = max3f(a, p1[i], p1[i + 1]); b = max3f(b, p1[i + 2], p1[i + 3]); }
    const float mx = half_max2(max2f(a, b));
    if (first || __builtin_amdgcn_ballot_w64(mx > 8.0f) != 0ull) {
        const float up = first ? mx : max2f(mx, 0.f);
        if (!first) { const float alpha = __builtin_amdgcn_exp2f(-up); l *= alpha;
#pragma unroll
            for (int d = 0; d < ND; ++d) o[d] = o[d] * alpha; }
        m += up;
        p0 = p0 - up; p1 = p1 - up; negm = negm - up;
        if (NEXT) { n0 = n0 - up; n1 = n1 - up; }
    }
    float rs = 0.f;
#pragma unroll
    for (int i = 0; i < 16; ++i) { p0[i] = __builtin_amdgcn_exp2f(p0[i]); p1[i] = __builtin_amdgcn_exp2f(p1[i]); rs += p0[i] + p1[i]; }
    l += rs;
#pragma unroll
    for (int s = 0; s < 2; ++s) {
        u32x4 w0, w1;
        w0.x = pk2(p0[8 * s + 0], p0[8 * s + 1]); w0.y = pk2(p0[8 * s + 2], p0[8 * s + 3]); w0.z = pk2(p0[8 * s + 4], p0[8 * s + 5]); w0.w = pk2(p0[8 * s + 6], p0[8 * s + 7]);
        w1.x = pk2(p1[8 * s + 0], p1[8 * s + 1]); w1.y = pk2(p1[8 * s + 2], p1[8 * s + 3]); w1.z = pk2(p1[8 * s + 4], p1[8 * s + 5]); w1.w = pk2(p1[8 * s + 6], p1[8 * s + 7]);
        pb[0][s] = __builtin_bit_cast(bf16x8, w0); pb[1][s] = __builtin_bit_cast(bf16x8, w1);
    }
}
#define SCHED_FENCE() __builtin_amdgcn_sched_barrier(0)
template <int ND, int VS>
__device__ __forceinline__ void pv_load(s16x4 (&v)[2][2], LAS const unsigned char* vb, int voff, int g) {
    const int ks = g / (ND / 2), dh = g % (ND / 2);
    LAS const unsigned char* a = vb + voff + ((ks >> 1) * 32 + (ks & 1) * 16) * VS + dh * 128;
#pragma unroll
    for (int j = 0; j < 2; ++j) { v[j][0] = vtr(a + j * 64); v[j][1] = vtr(a + 8 * VS + j * 64); }
}
template <int ND>
__device__ __forceinline__ void pv_mma(f32x16 (&o)[ND], const s16x4 (&v)[2][2], const bf16x8 (&pb)[2][2], int g) {
    const int ks = g / (ND / 2), dh = g % (ND / 2);
#pragma unroll
    for (int j = 0; j < 2; ++j) { const bf16x8 vf = {v[j][0][0], v[j][0][1], v[j][0][2], v[j][0][3], v[j][1][0], v[j][1][1], v[j][1][2], v[j][1][3]};
        o[2 * dh + j] = MFMA32(vf, pb[ks >> 1][ks & 1], o[2 * dh + j]); }
}
template <int ND, int VS>
__device__ __forceinline__ void pv_rest(f32x16 (&o)[ND], s16x4 (&vA)[2][2], const bf16x8 (&pb)[2][2], LAS const unsigned char* vb, int voff) {
    s16x4 vB[2][2];
#pragma unroll
    for (int g = 0; g < 2 * ND; g += 2) {
        pv_load<ND, VS>(vB, vb, voff, g + 1); SCHED_FENCE(); pv_mma<ND>(o, vA, pb, g); SCHED_FENCE();
        if (g + 2 < 2 * ND) { pv_load<ND, VS>(vA, vb, voff, g + 2); SCHED_FENCE(); }
        pv_mma<ND>(o, vB, pb, g + 1); SCHED_FENCE();
    }
}

__device__ __forceinline__ void attn_window_phase(const Params& P, LAS unsigned char* lds) {
    constexpr int KS = 144, VS = 192, STAGE = 64 * KS + 64 * VS;
    int tid_ = threadIdx.x; asm volatile("" : "+v"(tid_));
    const int tid = tid_, lane = tid & 63, wave = __builtin_amdgcn_readfirstlane(tid >> 6), r = lane & 31, hi = lane >> 5;
    const bf16_t* Q = (const bf16_t*)(P.ws + WS_Q); const bf16_t* Kg = (const bf16_t*)(P.ws + WS_K); const bf16_t* Vg = (const bf16_t*)(P.ws + WS_V);
    bf16_t* AO = (bf16_t*)(P.ws + WS_AO);
    const int voff = (4 * hi + ((lane & 15) >> 2)) * VS + (16 * ((lane >> 4) & 1) + 4 * (lane & 3)) * 2;
    const int lkey = tid >> 3, lch = tid & 7;
    for (int u = blockIdx.x; u < 2304; u += gridDim.x) {
        int b, hk, sb; bool isctx;
        if (u < 2048) { const int c = u & 255, i = u >> 8; b = i * 2 + (c & 1); hk = (c >> 1) & 1; sb = c >> 2; isctx = false; }
        else { const int c = u - 2048; b = c & 15; hk = (c >> 4) & 1; sb = c >> 5; isctx = true; }
        const int q0 = sb * 32;
        const int qrow0 = isctx ? ML + b * CTXL + q0 : b * SEQ + q0;
        int klo = 0, nlat = 0;
        if (!isctx) { klo = (q0 - 128 > 0 ? q0 - 128 : 0) & ~63; int khi = (q0 + 160 + 63) & ~63; if (khi > SEQ) khi = SEQ; nlat = (khi - klo) >> 6; }
        const int nt = nlat + 4;
        const int h = hk * 8 + wave;
        bf16x8 qf[4];
        { const bf16_t* qp = Q + (size_t)(qrow0 + r) * DM + h * 64 + 8 * hi;
#pragma unroll
          for (int d0 = 0; d0 < 4; ++d0) qf[d0] = *(const bf16x8*)(qp + d0 * 16); }
        float m = P.in[14][h] * LOG2E, l = hi ? 0.f : 1.f;
        f32x16 o[2], negm;
#pragma unroll
        for (int i = 0; i < 16; ++i) { o[0][i] = 0.f; o[1][i] = 0.f; negm[i] = -m; }
        u32x4 kreg, vreg;
#define TILE_ROW0(t) ((t) < nlat ? b * SEQ + klo + (t) * 64 : ML + b * CTXL + ((t) - nlat) * 64)
#define LOAD_TILE0(t) do { const size_t go = (size_t)(TILE_ROW0(t) + lkey) * 128 + hk * 64 + lch * 8; kreg = *(const u32x4*)(Kg + go); vreg = *(const u32x4*)(Vg + go); } while (0)
#define STORE_TILE0(st) do { *(LAS u32x4*)((st) + lkey * KS + lch * 16) = kreg; *(LAS u32x4*)((st) + 64 * KS + lkey * VS + lch * 16) = vreg; } while (0)
#define QK_TILE0(st, a0, a1) do { _Pragma("unroll") for (int d0 = 0; d0 < 4; ++d0) { \
                const bf16x8 k0 = *(const LAS bf16x8*)((st) + r * KS + d0 * 32 + hi * 16), k1 = *(const LAS bf16x8*)((st) + (32 + r) * KS + d0 * 32 + hi * 16); \
                a0 = MFMA32(k0, qf[d0], d0 == 0 ? negm : a0); a1 = MFMA32(k1, qf[d0], d0 == 0 ? negm : a1); } } while (0)
        LOAD_TILE0(0); STORE_TILE0(lds); LOAD_TILE0(1); STORE_TILE0(lds + STAGE); __syncthreads();
        f32x16 pc0, pc1;
        QK_TILE0(lds, pc0, pc1);
        int oc = 0, on = STAGE, ow = 2 * STAGE;
        for (int t = 0; t < nt; ++t) {
            if (t + 2 < nt) LOAD_TILE0(t + 2);
            f32x16 pn0, pn1;
            QK_TILE0(lds + on, pn0, pn1);
            s16x4 vA[2][2];
            pv_load<2, VS>(vA, lds + oc + 64 * KS, voff, 0); SCHED_FENCE();
            if (t < nlat) {
                const int D = klo + t * 64 - q0;
                const int dbase = D + 4 * hi - r;
                if (D < -97 || D > 65) {
#pragma unroll
                    for (int i = 0; i < 16; ++i) { const int d = dbase + (i & 3) + 8 * (i >> 2);
                        if (d > 128 || d < -128) pc0[i] = -1e30f;
                        if (d + 32 > 128 || d + 32 < -128) pc1[i] = -1e30f; }
                }
            }
            bf16x8 pb[2][2];
            softmax_tile<2, true>(pc0, pc1, pn0, pn1, negm, m, l, o, pb, false);
            SCHED_FENCE();
            pv_rest<2, VS>(o, vA, pb, lds + oc + 64 * KS, voff);
            if (t + 2 < nt) STORE_TILE0(lds + ow);
            __syncthreads();
            pc0 = pn0; pc1 = pn1;
            const int tmpo = oc; oc = on; on = ow; ow = tmpo;
        }
#undef TILE_ROW0
#undef LOAD_TILE0
#undef STORE_TILE0
#undef QK_TILE0
        const float inv = 1.f / half_sum(l);
        bf16_t* op = AO + (size_t)(qrow0 + r) * DM + h * 64 + 4 * hi;
#pragma unroll
        for (int d0 = 0; d0 < 2; ++d0)
#pragma unroll
            for (int tq = 0; tq < 4; ++tq) { u32x2 w; w.x = pk2(o[d0][4 * tq] * inv, o[d0][4 * tq + 1] * inv); w.y = pk2(o[d0][4 * tq + 2] * inv, o[d0][4 * tq + 3] * inv);
                *(u32x2*)(op + d0 * 32 + 8 * tq) = w; }
    }
}

__device__ __forceinline__ void attn_diff_phase(const Params& P, LAS unsigned char* lds) {
    constexpr int KS = 272, VS = 320, STAGE = 64 * KS + 64 * VS;
    int tid_ = threadIdx.x; asm volatile("" : "+v"(tid_));
    const int tid = tid_, lane = tid & 63, wave = __builtin_amdgcn_readfirstlane(tid >> 6), r = lane & 31, hi = lane >> 5;
    const int tmap = wave >> 2, sq = wave & 3;
    const bf16_t* Q = (const bf16_t*)(P.ws + WS_Q); const bf16_t* Kg = (const bf16_t*)(P.ws + WS_K); const bf16_t* Vg = (const bf16_t*)(P.ws + WS_V);
    bf16_t* AO = (bf16_t*)(P.ws + WS_AO);
    const float lam = ((const float*)(P.ws + WS_MISC))[0];
    const float* subg = P.in[23];
    const int voff = (4 * hi + ((lane & 15) >> 2)) * VS + (16 * ((lane >> 4) & 1) + 4 * (lane & 3)) * 2;
    const int lkey = tid >> 4, lch = tid & 15;
    LAS float* xch = (LAS float*)lds;
    if (tmap == 0) __builtin_amdgcn_s_setprio(1);
    for (int u = blockIdx.x; u < 2048; u += gridDim.x) {
        const int c = u & 255, i = u >> 8; const int h = c & 7, qb = (c >> 3) & 15, b = i * 2 + (c >> 7);
        const int qrow0 = b * SEQ + qb * 128 + sq * 32;
        bf16x8 qf[4];
        { const bf16_t* qp = Q + (size_t)(qrow0 + r) * DM + (h * 2 + tmap) * 64 + 8 * hi;
#pragma unroll
          for (int d0 = 0; d0 < 4; ++d0) qf[d0] = *(const bf16x8*)(qp + d0 * 16); }
        float m = 0.f, l = 0.f;
        f32x16 o[4], negm;
#pragma unroll
        for (int i2 = 0; i2 < 16; ++i2) { negm[i2] = 0.f;
#pragma unroll
            for (int d = 0; d < 4; ++d) o[d][i2] = 0.f; }
        u32x4 kreg[2], vreg[2];
#define TILE_ROW1(t) ((t) < 32 ? b * SEQ + (t) * 64 : ML + b * CTXL + ((t) - 32) * 64)
#define LOAD_TILE1(t) do { const size_t go = (size_t)(TILE_ROW1(t) + lkey) * DM + h * 128 + lch * 8; kreg[0] = *(const u32x4*)(Kg + go); vreg[0] = *(const u32x4*)(Vg + go); \
                           kreg[1] = *(const u32x4*)(Kg + go + 32 * DM); vreg[1] = *(const u32x4*)(Vg + go + 32 * DM); } while (0)
#define STORE_TILE1(st) do { *(LAS u32x4*)((st) + lkey * KS + lch * 16) = kreg[0]; *(LAS u32x4*)((st) + (lkey + 32) * KS + lch * 16) = kreg[1]; \
                             *(LAS u32x4*)((st) + 64 * KS + lkey * VS + lch * 16) = vreg[0]; *(LAS u32x4*)((st) + 64 * KS + (lkey + 32) * VS + lch * 16) = vreg[1]; } while (0)
#define QK_TILE1(st, a0, a1) do { _Pragma("unroll") for (int d0 = 0; d0 < 4; ++d0) { \
                const bf16x8 k0 = *(const LAS bf16x8*)((st) + r * KS + tmap * 128 + d0 * 32 + hi * 16), k1 = *(const LAS bf16x8*)((st) + (32 + r) * KS + tmap * 128 + d0 * 32 + hi * 16); \
                a0 = MFMA32(k0, qf[d0], d0 == 0 ? negm : a0); a1 = MFMA32(k1, qf[d0], d0 == 0 ? negm : a1); } } while (0)
        LOAD_TILE1(0); STORE_TILE1(lds); LOAD_TILE1(1); STORE_TILE1(lds + STAGE); __syncthreads();
        f32x16 pc0, pc1;
        QK_TILE1(lds, pc0, pc1);
        int oc = 0, on = STAGE, ow = 2 * STAGE;
        for (int t = 0; t < 36; ++t) {
            if (t + 2 < 36) LOAD_TILE1(t + 2);
            f32x16 pn0, pn1;
            QK_TILE1(lds + on, pn0, pn1);
            bf16x8 pb[2][2];
            softmax_tile<4, true>(pc0, pc1, pn0, pn1, negm, m, l, o, pb, t == 0);
            SCHED_FENCE();
            s16x4 vA[2][2];
            pv_load<4, VS>(vA, lds + oc + 64 * KS, voff, 0);
            pv_rest<4, VS>(o, vA, pb, lds + oc + 64 * KS, voff);
            if (t + 2 < 36) STORE_TILE1(lds + ow);
            __syncthreads();
            pc0 = pn0; pc1 = pn1;
            const int tmpo = oc; oc = on; on = ow; ow = tmpo;
        }
#undef QK_TILE1
#undef TILE_ROW1
#undef LOAD_TILE1
#undef STORE_TILE1
        const float inv = (tmap ? lam : 1.f) / half_sum(l);
        if (tmap == 1) {
#pragma unroll
            for (int d0 = 0; d0 < 4; ++d0)
#pragma unroll
                for (int i2 = 0; i2 < 16; ++i2) xch[(sq * 64 + d0 * 16 + i2) * 64 + lane] = o[d0][i2] * inv;
        }
        __syncthreads();
        if (tmap == 0) {
            float ss = 0.f;
#pragma unroll
            for (int d0 = 0; d0 < 4; ++d0)
#pragma unroll
                for (int i2 = 0; i2 < 16; ++i2) { const float v = o[d0][i2] * inv - xch[(sq * 64 + d0 * 16 + i2) * 64 + lane]; o[d0][i2] = v; ss += v * v; }
            ss = half_sum(ss);
            const float rs = (1.f - LAM_INIT) / sqrtf(ss * (1.f / 128.f) + 1e-5f);
            bf16_t* op = AO + (size_t)(qrow0 + r) * DM + h * 128 + 4 * hi;
#pragma unroll
            for (int d0 = 0; d0 < 4; ++d0)
#pragma unroll
                for (int tq = 0; tq < 4; ++tq) { const f32x4 g = *(const f32x4*)(subg + d0 * 32 + 8 * tq + 4 * hi);
                    u32x2 w; w.x = pk2(o[d0][4 * tq] * rs * g.x, o[d0][4 * tq + 1] * rs * g.y); w.y = pk2(o[d0][4 * tq + 2] * rs * g.z, o[d0][4 * tq + 3] * rs * g.w);
                    *(u32x2*)(op + d0 * 32 + 8 * tq) = w; }
        }
        __syncthreads();
    }
    __builtin_amdgcn_s_setprio(0);
}
__global__ void __launch_bounds__(512) fwd_megakernel(Params P) {
    extern __shared__ __attribute__((aligned(16))) unsigned char lds_raw[];
    LAS unsigned char* lds = (LAS unsigned char*)lds_raw;
    cg::grid_group grid = cg::this_grid();
    unsigned char* ws = P.ws;
    float* mod = (float*)(ws + WS_MOD);
    float* XC = (float*)(ws + WS_XC);
    bf16_t* HB = (bf16_t*)(ws + WS_HB);
    bf16_t* Qb = (bf16_t*)(ws + WS_Q); bf16_t* Kb = (bf16_t*)(ws + WS_K); bf16_t* Vb = (bf16_t*)(ws + WS_V); bf16_t* AO = (bf16_t*)(ws + WS_AO);
    bf16_t* HM = (bf16_t*)(ws + WS_HMID);
    const int G = gridDim.x, bid = blockIdx.x;

    unsigned* barw = (unsigned*)(ws + WS_BAR);
    if (bid == 0) for (int i = threadIdx.x; i < XCD_BAR_WORDS; i += 512) barw[i] = 0u;
    if (threadIdx.x < 2) ((LAS unsigned*)(lds + LDS_BARST))[threadIdx.x] = 0u;
    phase_mods(P, lds);
    __syncthreads();
    phase_weights(P, lds);
    grid.sync();
    (void)xcd_barrier_post(barw, (volatile LAS unsigned*)(lds + LDS_BARST));
#define GRID_SYNC() do { XcdBarrier bar_; bar_.bar = (unsigned*)(P.ws + WS_BAR); bar_.x = xb_xcc_id(); bar_.st = (volatile LAS unsigned*)(lds + LDS_BARST); xcd_barrier(bar_); } while (0)
    row_phase<false>(0, MT, 0, G, P.in[0], P.in[2], nullptr, nullptr, nullptr, nullptr, mod, 0, 1, HB);
    GRID_SYNC();

    for (int layer = 0; layer < 2; ++layer) {
        const int Mrows = layer == 0 ? MT : ML;
        const float* modl = mod + (size_t)layer * 17 * NMODC;
        {
            const int KW = layer == 0 ? 128 : DM;
            pg8::Gemm g{HB, (const bf16_t*)(ws + (layer == 0 ? WS_WQKV0 : WS_WQKV1)), MT, DM + 2 * KW, DM};
            pg8::StaticOrder S; S.init(g.M, g.N, G, bid);
            pg8::EpiQKV E{Qb, Kb, Vb, KW, 0.125f * LOG2E};
            pg8::gemm_phase<pg8::EpiQKV, pg8::StaticOrder, true, true>(lds, g, S, E);
        }
        GRID_SYNC();
        if (layer == 0) attn_window_phase(P, lds); else attn_diff_phase(P, lds);
        GRID_SYNC();
        {
            pg8::Gemm g{AO, (const bf16_t*)(ws + (layer == 0 ? WS_WO0 : WS_WO1)), Mrows, DM, DM};
            pg8::StaticOrder S; S.init(g.M, g.N, G, bid);
            pg8::EpiResid E{layer == 0 ? P.in[0] : P.out, layer == 0 ? P.in[2] : XC, P.out, XC, modl + 2 * DM, 0};
            pg8::gemm_phase<pg8::EpiResid, pg8::StaticOrder, true, true>(lds, g, S, E);
        }
        GRID_SYNC();
        row_phase<true>(0, Mrows, 0, G, P.out, XC, P.out, XC, P.in[6] + layer * DM, P.in[7] + layer * DM, modl, 3, 4, HB);
        GRID_SYNC();
        {
            pg8::Gemm g{HB, (const bf16_t*)(ws + (layer == 0 ? WS_W10 : WS_W11)), Mrows, FF, DM};
            pg8::StaticOrder S; S.init(g.M, g.N, G, bid);
            pg8::EpiRelu2 E{HM, FF};
            pg8::gemm_phase<pg8::EpiRelu2, pg8::StaticOrder, true, true>(lds, g, S, E);
        }
        GRID_SYNC();
        {
            pg8::Gemm g{HM, (const bf16_t*)(ws + (layer == 0 ? WS_W20 : WS_W21)), ML, DM, FF};
            pg8::StaticOrder S; S.init(g.M, g.N, G, bid);
            pg8::EpiResid E{P.out, XC, P.out, XC, modl + 5 * DM, 0};
            pg8::gemm_phase<pg8::EpiResid, pg8::StaticOrder, true, true>(lds, g, S, E);
        }
        GRID_SYNC();
        const int NCG = (layer == 0 && G >= 128) ? 64 : 0;
        if (layer == 0) {
            if (bid < NCG || NCG == 0) {
                pg8::Gemm g{HM + (size_t)ML * FF, (const bf16_t*)(ws + WS_W20), MC, DM, FF};
                pg8::StaticOrder S; S.init(g.M, g.N, NCG ? NCG : G, bid);
                pg8::EpiResid E{P.out, XC, P.out, XC, modl + 5 * DM, ML};
                pg8::gemm_phase<pg8::EpiResid, pg8::StaticOrder, true, true>(lds, g, S, E);
            }
            if (NCG == 0) GRID_SYNC();
        }
        row_phase<true>(0, ML, NCG, G - NCG, P.out, XC, P.out, XC, P.in[8] + layer * DM, P.in[9] + layer * DM, modl + 17 * NMODC, 0, 1, layer == 0 ? HB : nullptr);
        if (layer == 0) {
            GRID_SYNC();
            row_phase<true>(ML, MT, 0, G, P.out, XC, P.out, XC, P.in[8] + layer * DM, P.in[9] + layer * DM, modl + 17 * NMODC, 0, 1, HB);
        }
        if (layer == 0) GRID_SYNC();
    }
}

extern "C" void kernel_launch(void* const* d_in, const int* in_sizes, int n_in, void* d_out, int out_size, void* d_ws, size_t ws_size, hipStream_t stream) {
    static int grid_blocks = 0;
    if (grid_blocks == 0) {
        if (n_in != 26 || out_size != ML * DM || ws_size < WS_END) { fprintf(stderr, "kernel_launch: unexpected shapes (n_in %d out %d ws %zu)\n", n_in, out_size, ws_size); grid_blocks = -1; return; }
        int dev = 0, cus = 0, per_cu = 0;
        hipGetDevice(&dev);
        hipDeviceGetAttribute(&cus, hipDeviceAttributeMultiprocessorCount, dev);
        hipFuncSetAttribute((const void*)fwd_megakernel, hipFuncAttributeMaxDynamicSharedMemorySize, LDS_BYTES);
        hipOccupancyMaxActiveBlocksPerMultiprocessor(&per_cu, (const void*)fwd_megakernel, 512, LDS_BYTES);
        if (per_cu < 1) { fprintf(stderr, "kernel_launch: occupancy query reports %d blocks per CU\n", per_cu); per_cu = 1; }
        grid_blocks = cus * per_cu;
        (void)hipGetLastError();
    }
    if (grid_blocks < 0) return;
    Params p{};
    for (int i = 0; i < 26; ++i) p.in[i] = (const float*)d_in[i];
    p.out = (float*)d_out; p.ws = (unsigned char*)d_ws;
    void* args[] = {&p};
    hipError_t e = hipLaunchCooperativeKernel((const void*)fwd_megakernel, dim3(grid_blocks), dim3(512), args, LDS_BYTES, stream);
    if (e != hipSuccess) fprintf(stderr, "cooperative launch failed: %s (grid %d)\n", hipGetErrorString(e), grid_blocks);
}
```

```cpp
#include <hip/hip_runtime.h>
#include <hip/hip_cooperative_groups.h>
#include <cstdio>
#include <cstdint>
namespace cg = cooperative_groups;

constexpr int NB = 16, SEQ = 2048, CTXL = 256, DM = 1024, FF = 4096;
constexpr int ML = NB * SEQ, MC = NB * CTXL, MT = ML + MC;
constexpr int NMODC = 6 * DM;
constexpr float LOG2E = 1.4426950408889634f;
constexpr float DN_ALPHA = 1.4142135623730951f;
constexpr float LAM_INIT = 0.35550906759096926f;

namespace pg8 {
#define PG8_LAS __attribute__((address_space(3)))
typedef unsigned short bf16_t;
typedef short bf16x8 __attribute__((ext_vector_type(8)));
typedef float f32x4 __attribute__((ext_vector_type(4)));
typedef unsigned u32x4 __attribute__((ext_vector_type(4)));
constexpr int BM = 256, BK = 64, HALF = 128, HTB = HALF * BK * 2  , STAGE_BYTES = 8 * HTB, NXCD = 8, WGM = 8;

__host__ __device__ __forceinline__ int lds_byte(int r, int c) { const int st = (r >> 4) * 2 + (c >> 5), rr = r & 15, cc = c & 31, ob = rr * 64 + cc * 2; return st * 1024 + (ob ^ (((ob >> 9) & 1) << 5)); }
__host__ __device__ __forceinline__ void stage_rc(int b, int& R, int& C) { const int st = b / 1024, sb = b % 1024, swz = sb ^ (((sb >> 9) & 1) << 5); R = (st >> 1) * 16 + swz / 64; C = (st & 1) * 32 + (swz % 64) / 2; }
__host__ __device__ __forceinline__ int perm32(int rho) { const int n = rho >> 4, i = rho & 15; return 8 * (i >> 2) + 4 * n + (i & 3); }

struct Unit { int pm, pn; };
struct Gemm { const bf16_t* A; const bf16_t* Bt; int M, N, K; };

struct StaticOrder {
    int nM, nN, nwg, G, c;
    __host__ __device__ void init(int M, int N, int G_, int c_) { nM = M / BM; nN = N / BM; nwg = nM * nN; G = G_; c = c_; }
    __host__ __device__ bool next(int i, Unit& u) const {
        const long L = (long)i * G + c; if (L >= nwg) return false;
        int wgid = (int)L; { const int q = nwg / NXCD, r = nwg % NXCD, xcd = wgid % NXCD, off = wgid / NXCD; wgid = (xcd < r ? xcd * (q + 1) : r * (q + 1) + (xcd - r) * q) + off; }
        const int nig = WGM * nN, gid = wgid / nig, fm = gid * WGM, gsz = (nM - fm) < WGM ? (nM - fm) : WGM;
        u.pm = fm + ((wgid % nig) % gsz); u.pn = (wgid % nig) / gsz; return true;
    }
    __device__ __forceinline__ void a_ready(const Unit&) const {}
    __device__ __forceinline__ void done(const Unit&) const {}
};

__device__ __forceinline__ unsigned cvt_pk_bf16(float lo, float hi) { unsigned r; asm volatile("v_cvt_pk_bf16_f32 %0, %1, %2" : "=v"(r) : "v"(lo), "v"(hi)); return r; }
typedef float f32x2 __attribute__((ext_vector_type(2)));
typedef unsigned u32x2 __attribute__((ext_vector_type(2)));
struct EpiQKV {
    static constexpr bool PERM = true, AFTER_DRAIN = false;
    bf16_t *Q, *Kb, *Vb; int KW; float qscale;
    __device__ __forceinline__ void operator()(const f32x4 (&acc)[2][2][4][2], const Unit& u, int wr, int wc, int fr, int fq) const {
        const int row0 = u.pm * BM + wr * 64 + fr;
        const bool latent = (u.pm * BM) < ML;
        float invf[4];
#pragma unroll
        for (int e = 0; e < 4; ++e) invf[e] = __builtin_amdgcn_exp2f(-(float)(4 * fq + e) * (13.287712379549449f / 16.0f));
#pragma unroll
        for (int bj = 0; bj < 2; ++bj) {
            const int ctile = u.pn * BM + bj * HALF;
            bf16_t* dst; int ld, cbase; bool rope; float sc;
            if (ctile < DM) { dst = Q; ld = DM; cbase = ctile; rope = true; sc = qscale; }
            else if (ctile < DM + KW) { dst = Kb; ld = KW; cbase = ctile - DM; rope = true; sc = 1.f; }
            else { dst = Vb; ld = KW; cbase = ctile - DM - KW; rope = false; sc = 1.f; }
            rope = rope && latent;
            const int col0 = cbase + wc * 32 + 8 * fq;
#pragma unroll
            for (int ai = 0; ai < 2; ++ai)
#pragma unroll
                for (int m = 0; m < 4; ++m) {
                    const int row = row0 + ai * HALF + m * 16;
                    f32x4 v0 = acc[ai][bj][m][0], v1 = acc[ai][bj][m][1];
                    if (rope) {
                        const int t = row & (SEQ - 1);
                        const float pos = (float)((wc & 1) ? (t & 63) : (t >> 6));
                        f32x4 o0, o1;
#pragma unroll
                        for (int e = 0; e < 4; ++e) { const float ang = pos * invf[e]; const float cs = __cosf(ang), sn = __sinf(ang);
                            o0[e] = v0[e] * cs - v1[e] * sn; o1[e] = v0[e] * sn + v1[e] * cs; }
                        v0 = o0; v1 = o1;
                    }
                    v0 = v0 * sc; v1 = v1 * sc;
                    u32x4 w; w.x = cvt_pk_bf16(v0[0], v0[1]); w.y = cvt_pk_bf16(v0[2], v0[3]); w.z = cvt_pk_bf16(v1[0], v1[1]); w.w = cvt_pk_bf16(v1[2], v1[3]);
                    *(u32x4*)(dst + (size_t)row * ld + col0) = w;
                }
        }
    }
};
struct EpiRelu2 {
    static constexpr bool PERM = true, AFTER_DRAIN = false;
    bf16_t* O; int ldc;
    __device__ __forceinline__ void operator()(const f32x4 (&acc)[2][2][4][2], const Unit& u, int wr, int wc, int fr, int fq) const {
        const int row0 = u.pm * BM + wr * 64 + fr, col0 = u.pn * BM + wc * 32 + 8 * fq;
#pragma unroll
        for (int ai = 0; ai < 2; ++ai)
#pragma unroll
            for (int m = 0; m < 4; ++m) { bf16_t* rowp = O + (size_t)(row0 + ai * HALF + m * 16) * ldc + col0;
#pragma unroll
                for (int bj = 0; bj < 2; ++bj) { f32x4 v0 = acc[ai][bj][m][0], v1 = acc[ai][bj][m][1];
#pragma unroll
                    for (int e = 0; e < 4; ++e) { const float a = fmaxf(v0[e], 0.f), b = fmaxf(v1[e], 0.f); v0[e] = a * a; v1[e] = b * b; }
                    u32x4 w; w.x = cvt_pk_bf16(v0[0], v0[1]); w.y = cvt_pk_bf16(v0[2], v0[3]); w.z = cvt_pk_bf16(v1[0], v1[1]); w.w = cvt_pk_bf16(v1[2], v1[3]);
                    *(u32x4*)(rowp + bj * HALF) = w; } }
    }
};
struct EpiResid {
    static constexpr bool PERM = false, AFTER_DRAIN = false;
    const float *xl, *xc; float *yl, *yc; const float* gate;
    int row_base;
    __device__ __forceinline__ void operator()(const f32x4 (&acc)[2][2][4][2], const Unit& u, int wr, int wc, int fr, int fq) const {
        const int prow = u.pm * BM + row_base;
        const bool latent = prow < ML;
        const float* xin = latent ? xl + (size_t)prow * DM : xc + (size_t)(prow - ML) * DM;
        float* yout = latent ? yl + (size_t)prow * DM : yc + (size_t)(prow - ML) * DM;
        const float* gp = gate + (size_t)(latent ? (prow >> 11) : 16) * NMODC;
        const int col0 = u.pn * BM + wc * 32 + 4 * fq;
        f32x4 gv[2][2];
#pragma unroll
        for (int bj = 0; bj < 2; ++bj)
#pragma unroll
            for (int n = 0; n < 2; ++n) gv[bj][n] = *(const f32x4*)(gp + col0 + bj * HALF + n * 16);
#pragma unroll
        for (int ai = 0; ai < 2; ++ai)
#pragma unroll
            for (int m = 0; m < 4; ++m) { const size_t off = (size_t)(wr * 64 + fr + ai * HALF + m * 16) * DM + col0;
#pragma unroll
                for (int bj = 0; bj < 2; ++bj)
#pragma unroll
                    for (int n = 0; n < 2; ++n) { const f32x4 xv = *(const f32x4*)(xin + off + bj * HALF + n * 16);
                        *(f32x4*)(yout + off + bj * HALF + n * 16) = xv * DN_ALPHA + gv[bj][n] * acc[ai][bj][m][n]; } }
    }
};


template <class Epi, class Sched, bool ALIGN_EPI = false, bool SP2 = false>
__device__ __forceinline__ void gemm_phase(PG8_LAS unsigned char* lds, const Gemm g, const Sched& S, const Epi& E) {
    int tid_ = threadIdx.x; asm volatile("" : "+v"(tid_));
    const int tid = tid_, wid = __builtin_amdgcn_readfirstlane(tid >> 6), lane = tid & 63, wr = wid >> 2, wc = wid & 3, fr = lane & 15, fq = lane >> 4;
    const int K = g.K, nt = K / BK;
    unsigned voffA[2], voffB[2];
#pragma unroll
    for (int i = 0; i < 2; ++i) { int R, C; stage_rc(tid * 16 + i * 8192, R, C); const int Rb = Epi::PERM ? ((R & ~31) + perm32(R & 31)) : R;
        voffA[i] = (unsigned)(R * K + C) * 2u; voffB[i] = (unsigned)(Rb * K + C) * 2u; }
    const size_t kstep = (size_t)(BK * 2);
    const size_t hstep = (size_t)HALF * K * 2;
    const size_t tstep = 2 * hstep;
    const unsigned ldsw = (unsigned)wid * 1024u;
    const int aoff = lds_byte(wr * 64 + fr, fq * 8), boff = lds_byte(wc * 32 + fr, fq * 8);
#define PG8_SA(b, h) (((b) * 2 + (h)) * HTB)
#define PG8_SB(b, h) ((4 + (b) * 2 + (h)) * HTB)
#define PG8_STAGE(bufoff, gbase, voff) do { _Pragma("unroll") for (int _i = 0; _i < 2; ++_i) \
        __builtin_amdgcn_global_load_lds((const unsigned*)((const char*)(gbase) + (voff)[_i]), (PG8_LAS unsigned*)(lds + (bufoff) + ldsw + _i * 8192), 16, 0, 0); } while (0)
#define PG8_LDA(dst, b, h) do { _Pragma("unroll") for (int m = 0; m < 4; ++m) _Pragma("unroll") for (int k = 0; k < 2; ++k) dst[m][k] = *(const PG8_LAS bf16x8*)(lds + PG8_SA(b, h) + aoff + m * 2048 + k * 1024); } while (0)
#define PG8_LDB(dst, b, h) do { _Pragma("unroll") for (int n = 0; n < 2; ++n) _Pragma("unroll") for (int k = 0; k < 2; ++k) dst[n][k] = *(const PG8_LAS bf16x8*)(lds + PG8_SB(b, h) + boff + n * 2048 + k * 1024); } while (0)
#define PG8_MMA(ai, bj, At, Bt) do { __builtin_amdgcn_s_setprio(1); _Pragma("unroll") for (int m = 0; m < 4; ++m) _Pragma("unroll") for (int n = 0; n < 2; ++n) _Pragma("unroll") for (int k = 0; k < 2; ++k) \
        acc[ai][bj][m][n] = __builtin_amdgcn_mfma_f32_16x16x32_bf16(Bt[n][k], At[m][k], acc[ai][bj][m][n], 0, 0, 0); __builtin_amdgcn_s_setprio(0); } while (0)
#define PG8_WAIT_V(n) asm volatile("s_waitcnt vmcnt(" #n ")" ::: "memory")
#define PG8_WAIT_L(n) asm volatile("s_waitcnt lgkmcnt(" #n ")" ::: "memory")
#define PG8_BAR __builtin_amdgcn_s_barrier()
#define PG8_SCHED __builtin_amdgcn_sched_barrier(0)
    Unit cur, nxt; int ui = 0;
    if (!S.next(0, cur)) return;
    f32x4 acc[2][2][4][2];
#pragma unroll
    for (int a = 0; a < 2; ++a)
#pragma unroll
        for (int b = 0; b < 2; ++b)
#pragma unroll
            for (int m = 0; m < 4; ++m)
#pragma unroll
                for (int n = 0; n < 2; ++n) acc[a][b][m][n] = (f32x4){0.f, 0.f, 0.f, 0.f};
    bf16x8 At[4][2], B0[2][2], B1[2][2];
    const char* cA = (const char*)g.A + (size_t)cur.pm * tstep; const char* cB = (const char*)g.Bt + (size_t)cur.pn * tstep;
    S.a_ready(cur);
    if constexpr (SP2) {
        PG8_STAGE(PG8_SB(0, 0), cB, voffB); PG8_STAGE(PG8_SB(0, 1), cB + hstep, voffB); PG8_STAGE(PG8_SA(0, 0), cA, voffA); PG8_STAGE(PG8_SA(0, 1), cA + hstep, voffA);
        if (wr == 1) PG8_BAR;
        PG8_WAIT_V(2); PG8_BAR;
        PG8_STAGE(PG8_SB(1, 0), cB + kstep, voffB); PG8_STAGE(PG8_SA(1, 0), cA + kstep, voffA); PG8_STAGE(PG8_SB(1, 1), cB + hstep + kstep, voffB);
        PG8_WAIT_V(6); PG8_BAR;
    } else {
        PG8_STAGE(PG8_SB(0, 0), cB, voffB); PG8_STAGE(PG8_SA(0, 0), cA, voffA); PG8_STAGE(PG8_SB(0, 1), cB + hstep, voffB); PG8_STAGE(PG8_SA(0, 1), cA + hstep, voffA);
        if (wr == 1) PG8_BAR;
        PG8_WAIT_V(4); PG8_BAR;
        PG8_STAGE(PG8_SB(1, 0), cB + kstep, voffB); PG8_STAGE(PG8_SA(1, 0), cA + kstep, voffA); PG8_STAGE(PG8_SB(1, 1), cB + hstep + kstep, voffB);
        PG8_WAIT_V(6); PG8_BAR;
    }
    for (;;) {
        const bool has_next = S.next(ui + 1, nxt);
        const char* nA = has_next ? (const char*)g.A + (size_t)nxt.pm * tstep : cA; const char* nB = has_next ? (const char*)g.Bt + (size_t)nxt.pn * tstep : cB;
        for (int t = 0; t < nt; t += 2) {
            const bool last = (t == nt - 2);
            const char* a1 = cA + (size_t)(t + 1) * kstep;
            const char* a2 = last ? nA : cA + (size_t)(t + 2) * kstep; const char* b2 = last ? nB : cB + (size_t)(t + 2) * kstep;
            const char* a3 = a2 + kstep; const char* b3 = b2 + kstep;
            if (last && has_next) S.a_ready(nxt);
            if constexpr (SP2) {
            PG8_LDB(B0, 0, 0); PG8_LDB(B1, 0, 1); PG8_SCHED; PG8_LDA(At, 0, 0); PG8_STAGE(PG8_SA(1, 1), a1 + hstep, voffA);
            PG8_WAIT_V(8); PG8_WAIT_L(0); PG8_BAR; PG8_MMA(0, 0, At, B0); PG8_MMA(0, 1, At, B1); PG8_BAR; PG8_SCHED;
            PG8_LDA(At, 0, 1); PG8_STAGE(PG8_SB(0, 0), b2, voffB); PG8_STAGE(PG8_SB(0, 1), b2 + hstep, voffB); PG8_STAGE(PG8_SA(0, 0), a2, voffA);
            PG8_WAIT_V(8); PG8_WAIT_L(0); PG8_BAR; PG8_MMA(1, 0, At, B0); PG8_MMA(1, 1, At, B1); PG8_BAR; PG8_SCHED;
            PG8_LDB(B0, 1, 0); PG8_LDB(B1, 1, 1); PG8_SCHED; PG8_LDA(At, 1, 0); PG8_STAGE(PG8_SA(0, 1), a2 + hstep, voffA);
            PG8_WAIT_V(8); PG8_WAIT_L(0); PG8_BAR; PG8_MMA(0, 0, At, B0); PG8_MMA(0, 1, At, B1); PG8_BAR; PG8_SCHED;
            PG8_LDA(At, 1, 1); PG8_STAGE(PG8_SB(1, 0), b3, voffB); PG8_STAGE(PG8_SB(1, 1), b3 + hstep, voffB); PG8_STAGE(PG8_SA(1, 0), a3, voffA);
            PG8_WAIT_V(8); PG8_WAIT_L(0); PG8_BAR; PG8_MMA(1, 0, At, B0); PG8_MMA(1, 1, At, B1); PG8_BAR; PG8_SCHED;
            } else {
            PG8_LDB(B0, 0, 0); PG8_SCHED; PG8_LDA(At, 0, 0); PG8_STAGE(PG8_SA(1, 1), a1 + hstep, voffA);
            PG8_WAIT_L(8); PG8_BAR; PG8_WAIT_L(0); PG8_MMA(0, 0, At, B0); PG8_BAR; PG8_SCHED;
            PG8_LDB(B1, 0, 1); PG8_STAGE(PG8_SB(0, 0), b2, voffB);
            PG8_BAR; PG8_WAIT_L(0); PG8_MMA(0, 1, At, B1); PG8_BAR;
            PG8_LDA(At, 0, 1); PG8_STAGE(PG8_SA(0, 0), a2, voffA);
            PG8_BAR; PG8_WAIT_L(0); PG8_MMA(1, 0, At, B0); PG8_BAR; PG8_SCHED;
            PG8_STAGE(PG8_SB(0, 1), b2 + hstep, voffB);
            PG8_WAIT_V(6); PG8_BAR; PG8_MMA(1, 1, At, B1); PG8_BAR;
            PG8_LDB(B0, 1, 0); PG8_SCHED; PG8_LDA(At, 1, 0); PG8_STAGE(PG8_SA(0, 1), a2 + hstep, voffA);
            PG8_WAIT_L(8); PG8_BAR; PG8_WAIT_L(0); PG8_MMA(0, 0, At, B0); PG8_BAR; PG8_SCHED;
            PG8_LDB(B1, 1, 1); PG8_STAGE(PG8_SB(1, 0), b3, voffB);
            PG8_BAR; PG8_WAIT_L(0); PG8_MMA(0, 1, At, B1); PG8_BAR;
            PG8_LDA(At, 1, 1); PG8_STAGE(PG8_SA(1, 0), a3, voffA);
            PG8_BAR; PG8_WAIT_L(0); PG8_MMA(1, 0, At, B0); PG8_BAR; PG8_SCHED;
            PG8_STAGE(PG8_SB(1, 1), b3 + hstep, voffB);
            PG8_WAIT_V(6); PG8_BAR; PG8_MMA(1, 1, At, B1); PG8_BAR;
            }
        }
        if constexpr (ALIGN_EPI) { if (wr == 0) PG8_BAR; }
        if constexpr (!Epi::AFTER_DRAIN) { E(acc, cur, wr, wc, fr, fq); S.done(cur); }
        if (!has_next) break;
#pragma unroll
        for (int a = 0; a < 2; ++a)
#pragma unroll
            for (int b = 0; b < 2; ++b)
#pragma unroll
                for (int m = 0; m < 4; ++m)
#pragma unroll
                    for (int n = 0; n < 2; ++n) acc[a][b][m][n] = (f32x4){0.f, 0.f, 0.f, 0.f};
        cur = nxt; cA = nA; cB = nB; ++ui;
        if constexpr (ALIGN_EPI) { if (wr == 1) PG8_BAR; }
    }
    PG8_WAIT_V(0);
    if constexpr (!ALIGN_EPI) { if (wr == 0) PG8_BAR; }
    PG8_BAR;
    if constexpr (Epi::AFTER_DRAIN) { E.fused(acc, cur, wr, wc, fr, fq, lds, wid, lane); S.done(cur); }
#undef PG8_SA
#undef PG8_SB
#undef PG8_STAGE
#undef PG8_LDA
#undef PG8_LDB
#undef PG8_MMA
#undef PG8_WAIT_V
#undef PG8_WAIT_L
#undef PG8_BAR
#undef PG8_SCHED
}
}
#define LAS __attribute__((address_space(3)))
typedef unsigned short bf16_t;
typedef short bf16x8 __attribute__((ext_vector_type(8)));
typedef short s16x4 __attribute__((ext_vector_type(4)));
typedef float f32x4 __attribute__((ext_vector_type(4)));
typedef float f32x16 __attribute__((ext_vector_type(16)));
typedef unsigned u32x4 __attribute__((ext_vector_type(4)));
typedef unsigned u32x2 __attribute__((ext_vector_type(2)));
typedef float f32x2_t __attribute__((ext_vector_type(2)));
typedef __bf16 bf16x2_t __attribute__((ext_vector_type(2)));

constexpr size_t MiB = 1u << 20;
constexpr size_t WS_MISC = 0, WS_MOD = 1 * MiB;
constexpr size_t WS_WQKV0 = 2 * MiB, WS_WO0 = 5 * MiB, WS_W10 = 8 * MiB, WS_W20 = 16 * MiB;
constexpr size_t WS_WQKV1 = 24 * MiB, WS_WO1 = 30 * MiB, WS_W11 = 32 * MiB, WS_W21 = 40 * MiB;
constexpr size_t WS_XC = 48 * MiB;
constexpr size_t WS_HB = 64 * MiB;
constexpr size_t WS_Q = 136 * MiB, WS_K = 208 * MiB, WS_V = 280 * MiB, WS_AO = 352 * MiB;
constexpr size_t WS_HMID = 136 * MiB;
constexpr size_t WS_END = 424 * MiB;
constexpr int LDS_BYTES = 147456;

struct Params { const float* in[26]; float* out; unsigned char* ws; };
constexpr size_t WS_BAR = 65536;
constexpr int LDS_BARST = 131072 + 64;
#define XB_TMO      128
#define XB_XCNT(j)  (256  + 64 * (j))
#define XB_XSUB(j)  (1280 + 64 * (j))
#define XB_XGEN(j)  (2304 + 64 * (j))
#define XB_TOP      3328
#define XB_TOPGEN   3392
#define XCD_BAR_WORDS 3456
#define XB_SPIN_CAP (1u << 18)

__device__ __forceinline__ unsigned xb_ld(unsigned* p)              { return __hip_atomic_load(p, __ATOMIC_RELAXED, __HIP_MEMORY_SCOPE_AGENT); }
__device__ __forceinline__ unsigned xb_add(unsigned* p, unsigned v) { return __hip_atomic_fetch_add(p, v, __ATOMIC_RELAXED, __HIP_MEMORY_SCOPE_AGENT); }
__device__ __forceinline__ unsigned xb_xcc_id() { return (unsigned)__builtin_amdgcn_s_getreg((3 << 11) | 20) & 0xFu; }
#define XB_SPIN(cond, bar) do { unsigned _sp = 0; while (cond) { __builtin_amdgcn_s_sleep(1); \
    if ((++_sp & 255u) == 0u) { if (xb_ld(&(bar)[XB_TMO])) break; if (_sp > XB_SPIN_CAP) { atomicAdd(&(bar)[XB_TMO], 1u); break; } } } } while (0)

struct XcdBarrier {
    unsigned* bar; unsigned x;
    volatile LAS unsigned* st;
};

__device__ __forceinline__ XcdBarrier xcd_barrier_post(unsigned* bar, volatile LAS unsigned* st) {
    XcdBarrier b; b.bar = bar; b.x = xb_xcc_id(); b.st = st;
    if (threadIdx.x == 0) (void)xb_add(&bar[XB_XCNT(b.x)], 1u);
    return b;
}
__device__ __forceinline__ void xcd_barrier_complete(unsigned* bar, unsigned x, unsigned& nloc, unsigned& nx) {
    const unsigned G = gridDim.x * gridDim.y * gridDim.z;
    unsigned sum, cnt, mine, sp = 0u;
    for (;;) {
        sum = 0u; cnt = 0u; mine = 0u;
#pragma unroll
        for (unsigned j = 0; j < 16; ++j) { const unsigned c = xb_ld(&bar[XB_XCNT(j)]); sum += c; cnt += (c > 0u) ? 1u : 0u; mine = (j == x) ? c : mine; }
        if (sum == G) break;
        __builtin_amdgcn_s_sleep(1);
        if ((++sp & 255u) == 0u) { if (xb_ld(&bar[XB_TMO])) break; if (sp > XB_SPIN_CAP) { atomicAdd(&bar[XB_TMO], 1u); break; } }
    }
    nloc = mine > 0u ? mine : 1u; nx = cnt > 0u ? cnt : 1u;
}

__device__ __forceinline__ void xcd_barrier(const XcdBarrier& b) {
    asm volatile("s_waitcnt vmcnt(0)" ::: "memory");
    __syncthreads();
    if (threadIdx.x == 0) {
        unsigned* bar = b.bar;
        __builtin_amdgcn_s_waitcnt(0);
        unsigned nloc = b.st[0], nx = b.st[1];
        if (nloc == 0u) { xcd_barrier_complete(bar, b.x, nloc, nx); b.st[0] = nloc; b.st[1] = nx; }
        const unsigned old = xb_add(&bar[XB_XSUB(b.x)], 1u);
        const unsigned gen = old / nloc;
        if (old + 1u == (gen + 1u) * nloc) {
            __builtin_amdgcn_fence(__ATOMIC_RELEASE, "agent");
            asm volatile("s_waitcnt vmcnt(0)" ::: "memory");
            const unsigned og = xb_add(&bar[XB_TOP], 1u);
            const unsigned tg = og / nx;
            if (og + 1u == (tg + 1u) * nx) xb_add(&bar[XB_TOPGEN], 1u);
            else XB_SPIN(xb_ld(&bar[XB_TOPGEN]) == tg, bar);
            __builtin_amdgcn_fence(__ATOMIC_ACQUIRE, "agent");
            xb_add(&bar[XB_XGEN(b.x)], 1u);
            asm volatile("s_waitcnt vmcnt(0)" ::: "memory");
        } else {
            XB_SPIN(xb_ld(&bar[XB_XGEN(b.x)]) == gen, bar);
            __builtin_amdgcn_fence(__ATOMIC_ACQUIRE, "agent");
            asm volatile("s_waitcnt vmcnt(0)" ::: "memory");
        }
    }
    __syncthreads();
}


__device__ __forceinline__ unsigned pk2(float lo, float hi) { f32x2_t v = {lo, hi}; bf16x2_t b = __builtin_convertvector(v, bf16x2_t); return __builtin_bit_cast(unsigned, b); }
__device__ __forceinline__ float wave_sum(float v) {
#pragma unroll
    for (int o = 1; o < 64; o <<= 1) v += __shfl_xor(v, o);
    return v;
}
__device__ __forceinline__ float half_max(float m) { auto rr = __builtin_amdgcn_permlane32_swap(__float_as_uint(m), __float_as_uint(m), false, false); return fmaxf(__uint_as_float(rr[0]), __uint_as_float(rr[1])); }
__device__ __forceinline__ float half_sum(float m) { auto rr = __builtin_amdgcn_permlane32_swap(__float_as_uint(m), __float_as_uint(m), false, false); return __uint_as_float(rr[0]) + __uint_as_float(rr[1]); }
__device__ __forceinline__ s16x4 vtr(LAS const unsigned char* p) { typedef short v4i16_t __attribute__((ext_vector_type(4))); return __builtin_bit_cast(s16x4, __builtin_amdgcn_ds_read_tr16_b64_v4i16((LAS v4i16_t*)p)); }

__device__ __forceinline__ void phase_mods(const Params& P, LAS unsigned char* lds) {
    int tid_ = threadIdx.x; asm volatile("" : "+v"(tid_));
    const int tid = tid_, lane = tid & 63, wave = __builtin_amdgcn_readfirstlane(tid >> 6);
    float* mod = (float*)(P.ws + WS_MOD);
    if (blockIdx.x == gridDim.x - 1 && tid == 0) {
        float s1 = 0.f, s2 = 0.f;
        for (int i = 0; i < 64; ++i) { s1 += P.in[19][i] * P.in[20][i]; s2 += P.in[21][i] * P.in[22][i]; }
        ((float*)(P.ws + WS_MISC))[0] = __expf(s1) - __expf(s2) + LAM_INIT;
    }
    if (blockIdx.x >= 192) return;
    LAS float* S = (LAS float*)lds;
    LAS float* red = (LAS float*)(lds + 17 * 1024 * 4);
    for (int i = tid; i < 17 * 1024; i += 512) { const int r = i >> 10, k = i & 1023; const float v = r < 16 ? P.in[1][r * 1024 + k] : P.in[3][k]; S[i] = v / (1.f + __expf(-v)); }
    __syncthreads();
    for (int u = blockIdx.x; u < 192; u += gridDim.x) {
        const int l = u / 96, g = u % 96, n = g * 64 + lane;
        const float* W = P.in[4] + (size_t)l * DM * NMODC + n;
        float acc[17];
#pragma unroll
        for (int r = 0; r < 17; ++r) acc[r] = 0.f;
        const int k0 = wave * 128;
#pragma unroll 2
        for (int k = k0; k < k0 + 128; k += 4) {
            const float w0 = W[(size_t)k * NMODC], w1 = W[(size_t)(k + 1) * NMODC], w2 = W[(size_t)(k + 2) * NMODC], w3 = W[(size_t)(k + 3) * NMODC];
#pragma unroll
            for (int r = 0; r < 17; ++r) { const f32x4 s = *(const LAS f32x4*)(S + r * 1024 + k); acc[r] += (w0 * s.x + w1 * s.y) + (w2 * s.z + w3 * s.w); }
        }
#pragma unroll
        for (int r = 0; r < 17; ++r) red[(wave * 17 + r) * 64 + lane] = acc[r];
        __syncthreads();
        for (int idx = tid; idx < 17 * 64; idx += 512) { const int r = idx >> 6, ln = idx & 63; float s = 0.f;
#pragma unroll
            for (int w = 0; w < 8; ++w) s += red[(w * 17 + r) * 64 + ln];
            const int nn = g * 64 + ln; mod[(size_t)(l * 17 + r) * NMODC + nn] = s + P.in[5][l * NMODC + nn]; }
        __syncthreads();
    }
}
__device__ __forceinline__ unsigned f2bf(float f) { unsigned u = __builtin_bit_cast(unsigned, f); return (u + 0x7fffu + ((u >> 16) & 1u)) >> 16; }
__device__ __forceinline__ unsigned pk2i(float lo, float hi) { return f2bf(lo) | (f2bf(hi) << 16); }
__device__ __forceinline__ void transpose_item(const float* W, int K, int N, bf16_t* WT, int row_off, bool perm, LAS float* scr, int item, int lane) {
    const int nblk = N / 32, kb = item / nblk, nb = item % nblk, k0 = 64 * kb, n0 = 32 * nb;
    int sp = n0 + (lane & 31);
    if (perm) { const int p = sp & 63; sp = (sp & ~63) + 16 * (p >> 5) + 4 * ((p >> 3) & 3) + (p & 3) + 32 * ((p >> 2) & 1); }
#pragma unroll 8
    for (int i = 0; i < 32; ++i) { const int kk = 2 * i + (lane >> 5); scr[kk * 33 + (lane & 31)] = W[(size_t)(k0 + kk) * N + sp]; }
    asm volatile("s_waitcnt lgkmcnt(0)" ::: "memory");
    const int c = lane & 7;
#pragma unroll
    for (int j = 0; j < 4; ++j) { const int n = (lane >> 3) + 8 * j; const LAS float* s = scr + (8 * c) * 33 + n;
        u32x4 o; o.x = pk2i(s[0 * 33], s[1 * 33]); o.y = pk2i(s[2 * 33], s[3 * 33]); o.z = pk2i(s[4 * 33], s[5 * 33]); o.w = pk2i(s[6 * 33], s[7 * 33]);
        *(u32x4*)(WT + (size_t)(row_off + n0 + n) * K + k0 + 8 * c) = o; }
    asm volatile("s_waitcnt lgkmcnt(0)" ::: "memory");
}
__device__ __forceinline__ void phase_weights(const Params& P, LAS unsigned char* lds) {
    int tid_ = threadIdx.x; asm volatile("" : "+v"(tid_));
    const int lane = tid_ & 63, wave = __builtin_amdgcn_readfirstlane(tid_ >> 6);
    LAS float* scr = (LAS float*)(lds + wave * 16384);
    const int gw = blockIdx.x * 8 + wave, NGW = gridDim.x * 8;
    unsigned char* ws = P.ws;
    constexpr int I_DD = 16 * 32, I_DK0 = 16 * 4, I_1 = 16 * 128, I_2 = 64 * 32;
    constexpr int NITEMS = (I_DD + 2 * I_DK0 + I_DD + I_1 + I_2) + (4 * I_DD + I_1 + I_2);
    for (int it = gw; it < NITEMS; it += NGW) {
        int r = it;
#define TR_ITEM(cnt, W, K, N, WT, roff, perm) if (r < (cnt)) { transpose_item((W), (K), (N), (bf16_t*)(ws + (WT)), (roff), (perm), scr, r, lane); continue; } r -= (cnt);
        TR_ITEM(I_DD,  P.in[10], DM, DM,  WS_WQKV0, 0, true)
        TR_ITEM(I_DK0, P.in[11], DM, 128, WS_WQKV0, DM, true)
        TR_ITEM(I_DK0, P.in[12], DM, 128, WS_WQKV0, DM + 128, false)
        TR_ITEM(I_DD,  P.in[13], DM, DM,  WS_WO0, 0, false)
        TR_ITEM(I_1,   P.in[24], DM, FF,  WS_W10, 0, false)
        TR_ITEM(I_2,   P.in[25], FF, DM,  WS_W20, 0, false)
        TR_ITEM(I_DD,  P.in[15], DM, DM,  WS_WQKV1, 0, true)
        TR_ITEM(I_DD,  P.in[16], DM, DM,  WS_WQKV1, DM, true)
        TR_ITEM(I_DD,  P.in[17], DM, DM,  WS_WQKV1, 2 * DM, false)
        TR_ITEM(I_DD,  P.in[18], DM, DM,  WS_WO1, 0, false)
        TR_ITEM(I_1,   P.in[24] + (size_t)DM * FF, DM, FF, WS_W11, 0, false)
        TR_ITEM(I_2,   P.in[25] + (size_t)FF * DM, FF, DM, WS_W21, 0, false)
#undef TR_ITEM
    }
}
template <bool DO_LN>
__device__ __forceinline__ void row_phase(int row_lo, int nrows, int blk_lo, int nblk, const float* srcL, const float* srcC, float* dstL, float* dstC, const float* lng, const float* lnb,
                                          const float* modl  , int sh_chunk, int sc_chunk, bf16_t* HB) {
    int tid_ = threadIdx.x; asm volatile("" : "+v"(tid_));
    const int lane = tid_ & 63, wave = __builtin_amdgcn_readfirstlane(tid_ >> 6);
    const int gw = ((int)blockIdx.x - blk_lo) * 8 + wave, NGW = nblk * 8;
    if (gw < 0 || gw >= NGW) return;
    constexpr int RR = 4;
    for (int row = row_lo + gw * RR; row < nrows; row += NGW * RR) {
        const bool latent = row < ML;
        const size_t roff = latent ? (size_t)row * DM : (size_t)(row - ML) * DM;
        const f32x4* xr = (const f32x4*)((latent ? srcL : srcC) + roff) + lane;
        f32x4 v[RR][4];
#pragma unroll
        for (int rr = 0; rr < RR; ++rr)
#pragma unroll
            for (int j = 0; j < 4; ++j) v[rr][j] = xr[rr * (DM / 4) + 64 * j];
        if (DO_LN) {
            float s[RR];
#pragma unroll
            for (int rr = 0; rr < RR; ++rr) { s[rr] = 0.f;
#pragma unroll
                for (int j = 0; j < 4; ++j) s[rr] += (v[rr][j].x + v[rr][j].y) + (v[rr][j].z + v[rr][j].w); }
#pragma unroll
            for (int o = 1; o < 64; o <<= 1)
#pragma unroll
                for (int rr = 0; rr < RR; ++rr) s[rr] += __shfl_xor(s[rr], o);
            float q[RR];
#pragma unroll
            for (int rr = 0; rr < RR; ++rr) { const float mean = s[rr] * (1.f / DM); q[rr] = 0.f;
#pragma unroll
                for (int j = 0; j < 4; ++j) { v[rr][j] = v[rr][j] - mean; q[rr] += (v[rr][j].x * v[rr][j].x + v[rr][j].y * v[rr][j].y) + (v[rr][j].z * v[rr][j].z + v[rr][j].w * v[rr][j].w); } }
#pragma unroll
            for (int o = 1; o < 64; o <<= 1)
#pragma unroll
                for (int rr = 0; rr < RR; ++rr) q[rr] += __shfl_xor(q[rr], o);
            f32x4* yr = (f32x4*)((latent ? dstL : dstC) + roff) + lane;
#pragma unroll
            for (int j = 0; j < 4; ++j) { const f32x4 g = ((const f32x4*)lng)[lane + 64 * j], b = ((const f32x4*)lnb)[lane + 64 * j];
#pragma unroll
                for (int rr = 0; rr < RR; ++rr) { const float rstd = 1.f / sqrtf(q[rr] * (1.f / DM) + 1e-5f); v[rr][j] = v[rr][j] * rstd * g + b; yr[rr * (DM / 4) + 64 * j] = v[rr][j]; } }
        }
        if (HB) {
            const float* mrow = modl + (size_t)(latent ? (row >> 11) : 16) * NMODC;
            u32x2* hr = (u32x2*)(HB + (size_t)row * DM) + lane;
#pragma unroll
            for (int j = 0; j < 4; ++j) { const f32x4 sh = ((const f32x4*)(mrow + sh_chunk * DM))[lane + 64 * j], sc = ((const f32x4*)(mrow + sc_chunk * DM))[lane + 64 * j] + 1.0f;
#pragma unroll
                for (int rr = 0; rr < RR; ++rr) { const f32x4 h = v[rr][j] * sc + sh; u32x2 w; w.x = pk2(h.x, h.y); w.y = pk2(h.z, h.w); hr[rr * (DM / 4) + 64 * j] = w; } }
        }
    }
}
#define MFMA32(a, b, c) __builtin_amdgcn_mfma_f32_32x32x16_bf16((a), (b), (c), 0, 0, 0)
__device__ __forceinline__ float max3f(float a, float b, float c) { float r; asm("v_max3_f32 %0, %1, %2, %3" : "=v"(r) : "v"(a), "v"(b), "v"(c)); return r; }
__device__ __forceinline__ float max2f(float a, float b) { float r; asm("v_max_f32_e32 %0, %1, %2" : "=v"(r) : "v"(a), "v"(b)); return r; }
__device__ __forceinline__ float half_max2(float m) { auto rr = __builtin_amdgcn_permlane32_swap(__float_as_uint(m), __float_as_uint(m), false, false); return max2f(__uint_as_float(rr[0]), __uint_as_float(rr[1])); }
template <int ND, bool NEXT>
__device__ __forceinline__ void softmax_tile(f32x16& p0, f32x16& p1, f32x16& n0, f32x16& n1, f32x16& negm, float& m, float& l, f32x16 (&o)[ND], bf16x8 (&pb)[2][2], bool first) {
    float a = max3f(p0[0], p0[1], p1[0]), b = max3f(p0[2], p0[3], p1[1]); a = max3f(a, p1[2], p1[3]);
#pragma unroll
    for (int i = 4; i < 16; i += 4) { a = max3f(a, p0[i], p0[i + 1]); b = max3f(b, p0[i + 2], p0[i + 3]); a = max3f(a, p1[i], p1[i + 1]); b = max3f(b, p1[i + 2], p1[i + 3]); }
    const float mx = half_max2(max2f(a, b));
    if (first || __builtin_amdgcn_ballot_w64(mx > 8.0f) != 0ull) {
        const float up = first ? mx : max2f(mx, 0.f);
        if (!first) { const float alpha = __builtin_amdgcn_exp2f(-up); l *= alpha;
#pragma unroll
            for (int d = 0; d < ND; ++d) o[d] = o[d] * alpha; }
        m += up;
        p0 = p0 - up; p1 = p1 - up; negm = negm - up;
        if (NEXT) { n0 = n0 - up; n1 = n1 - up; }
    }
    float rs = 0.f;
#pragma unroll
    for (int i = 0; i < 16; ++i) { p0[i] = __builtin_amdgcn_exp2f(p0[i]); p1[i] = __builtin_amdgcn_exp2f(p1[i]); rs += p0[i] + p1[i]; }
    l += rs;
#pragma unroll
    for (int s = 0; s < 2; ++s) {
        u32x4 w0, w1;
        w0.x = pk2(p0[8 * s + 0], p0[8 * s + 1]); w0.y = pk2(p0[8 * s + 2], p0[8 * s + 3]); w0.z = pk2(p0[8 * s + 4], p0[8 * s + 5]); w0.w = pk2(p0[8 * s + 6], p0[8 * s + 7]);
        w1.x = pk2(p1[8 * s + 0], p1[8 * s + 1]); w1.y = pk2(p1[8 * s + 2], p1[8 * s + 3]); w1.z = pk2(p1[8 * s + 4], p1[8 * s + 5]); w1.w = pk2(p1[8 * s + 6], p1[8 * s + 7]);
        pb[0][s] = __builtin_bit_cast(bf16x8, w0); pb[1][s] = __builtin_bit_cast(bf16x8, w1);
    }
}
#define SCHED_FENCE() __builtin_amdgcn_sched_barrier(0)
template <int ND, int VS>
__device__ __forceinline__ void pv_load(s16x4 (&v)[2][2], LAS const unsigned char* vb, int voff, int g) {
    const int ks = g / (ND / 2), dh = g % (ND / 2);
    LAS const unsigned char* a = vb + voff + ((ks >> 1) * 32 + (ks & 1) * 16) * VS + dh * 128;
#pragma unroll
    for (int j = 0; j < 2; ++j) { v[j][0] = vtr(a + j * 64); v[j][1] = vtr(a + 8 * VS + j * 64); }
}
template <int ND>
__device__ __forceinline__ void pv_mma(f32x16 (&o)[ND], const s16x4 (&v)[2][2], const bf16x8 (&pb)[2][2], int g) {
    const int ks = g / (ND / 2), dh = g % (ND / 2);
#pragma unroll
    for (int j = 0; j < 2; ++j) { const bf16x8 vf = {v[j][0][0], v[j][0][1], v[j][0][2], v[j][0][3], v[j][1][0], v[j][1][1], v[j][1][2], v[j][1][3]};
        o[2 * dh + j] = MFMA32(vf, pb[ks >> 1][ks & 1], o[2 * dh + j]); }
}
template <int ND, int VS>
__device__ __forceinline__ void pv_rest(f32x16 (&o)[ND], s16x4 (&vA)[2][2], const bf16x8 (&pb)[2][2], LAS const unsigned char* vb, int voff) {
    s16x4 vB[2][2];
#pragma unroll
    for (int g = 0; g < 2 * ND; g += 2) {
        pv_load<ND, VS>(vB, vb, voff, g + 1); SCHED_FENCE(); pv_mma<ND>(o, vA, pb, g); SCHED_FENCE();
        if (g + 2 < 2 * ND) { pv_load<ND, VS>(vA, vb, voff, g + 2); SCHED_FENCE(); }
        pv_mma<ND>(o, vB, pb, g + 1); SCHED_FENCE();
    }
}

__device__ __forceinline__ void attn_window_phase(const Params& P, LAS unsigned char* lds) {
    constexpr int KS = 144, VS = 192, STAGE = 64 * KS + 64 * VS;
    int tid_ = threadIdx.x; asm volatile("" : "+v"(tid_));
    const int tid = tid_, lane = tid & 63, wave = __builtin_amdgcn_readfirstlane(tid >> 6), r = lane & 31, hi = lane >> 5;
    const bf16_t* Q = (const bf16_t*)(P.ws + WS_Q); const bf16_t* Kg = (const bf16_t*)(P.ws + WS_K); const bf16_t* Vg = (const bf16_t*)(P.ws + WS_V);
    bf16_t* AO = (bf16_t*)(P.ws + WS_AO);
    const int voff = (4 * hi + ((lane & 15) >> 2)) * VS + (16 * ((lane >> 4) & 1) + 4 * (lane & 3)) * 2;
    const int lkey = tid >> 3, lch = tid & 7;
    for (int u = blockIdx.x; u < 2304; u += gridDim.x) {
        int b, hk, sb; bool isctx;
        if (u < 2048) { const int c = u & 255, i = u >> 8; b = i * 2 + (c & 1); hk = (c >> 1) & 1; sb = c >> 2; isctx = false; }
        else { const int c = u - 2048; b = c & 15; hk = (c >> 4) & 1; sb = c >> 5; isctx = true; }
        const int q0 = sb * 32;
        const int qrow0 = isctx ? ML + b * CTXL + q0 : b * SEQ + q0;
        int klo = 0, nlat = 0;
        if (!isctx) { klo = (q0 - 128 > 0 ? q0 - 128 : 0) & ~63; int khi = (q0 + 160 + 63) & ~63; if (khi > SEQ) khi = SEQ; nlat = (khi - klo) >> 6; }
        const int nt = nlat + 4;
        const int h = hk * 8 + wave;
        bf16x8 qf[4];
        { const bf16_t* qp = Q + (size_t)(qrow0 + r) * DM + h * 64 + 8 * hi;
#pragma unroll
          for (int d0 = 0; d0 < 4; ++d0) qf[d0] = *(const bf16x8*)(qp + d0 * 16); }
        float m = P.in[14][h] * LOG2E, l = hi ? 0.f : 1.f;
        f32x16 o[2], negm;
#pragma unroll
        for (int i = 0; i < 16; ++i) { o[0][i] = 0.f; o[1][i] = 0.f; negm[i] = -m; }
        u32x4 kreg, vreg;
#define TILE_ROW0(t) ((t) < nlat ? b * SEQ + klo + (t) * 64 : ML + b * CTXL + ((t) - nlat) * 64)
#define LOAD_TILE0(t) do { const size_t go = (size_t)(TILE_ROW0(t) + lkey) * 128 + hk * 64 + lch * 8; kreg = *(const u32x4*)(Kg + go); vreg = *(const u32x4*)(Vg + go); } while (0)
#define STORE_TILE0(st) do { *(LAS u32x4*)((st) + lkey * KS + lch * 16) = kreg; *(LAS u32x4*)((st) + 64 * KS + lkey * VS + lch * 16) = vreg; } while (0)
#define QK_TILE0(st, a0, a1) do { _Pragma("unroll") for (int d0 = 0; d0 < 4; ++d0) { \
                const bf16x8 k0 = *(const LAS bf16x8*)((st) + r * KS + d0 * 32 + hi * 16), k1 = *(const LAS bf16x8*)((st) + (32 + r) * KS + d0 * 32 + hi * 16); \
                a0 = MFMA32(k0, qf[d0], d0 == 0 ? negm : a0); a1 = MFMA32(k1, qf[d0], d0 == 0 ? negm : a1); } } while (0)
        LOAD_TILE0(0); STORE_TILE0(lds); LOAD_TILE0(1); STORE_TILE0(lds + STAGE); __syncthreads();
        f32x16 pc0, pc1;
        QK_TILE0(lds, pc0, pc1);
        int oc = 0, on = STAGE, ow = 2 * STAGE;
        for (int t = 0; t < nt; ++t) {
            if (t + 2 < nt) LOAD_TILE0(t + 2);
            f32x16 pn0, pn1;
            QK_TILE0(lds + on, pn0, pn1);
            s16x4 vA[2][2];
            pv_load<2, VS>(vA, lds + oc + 64 * KS, voff, 0); SCHED_FENCE();
            if (t < nlat) {
                const int D = klo + t * 64 - q0;
                const int dbase = D + 4 * hi - r;
                if (D < -97 || D > 65) {
#pragma unroll
                    for (int i = 0; i < 16; ++i) { const int d = dbase + (i & 3) + 8 * (i >> 2);
                        if (d > 128 || d < -128) pc0[i] = -1e30f;
                        if (d + 32 > 128 || d + 32 < -128) pc1[i] = -1e30f; }
                }
            }
            bf16x8 pb[2][2];
            softmax_tile<2, true>(pc0, pc1, pn0, pn1, negm, m, l, o, pb, false);
            SCHED_FENCE();
            pv_rest<2, VS>(o, vA, pb, lds + oc + 64 * KS, voff);
            if (t + 2 < nt) STORE_TILE0(lds + ow);
            __syncthreads();
            pc0 = pn0; pc1 = pn1;
            const int tmpo = oc; oc = on; on = ow; ow = tmpo;
        }
#undef TILE_ROW0
#undef LOAD_TILE0
#undef STORE_TILE0
#undef QK_TILE0
        const float inv = 1.f / half_sum(l);
        bf16_t* op = AO + (size_t)(qrow0 + r) * DM + h * 64 + 4 * hi;
#pragma unroll
        for (int d0 = 0; d0 < 2; ++d0)
#pragma unroll
            for (int tq = 0; tq < 4; ++tq) { u32x2 w; w.x = pk2(o[d0][4 * tq] * inv, o[d0][4 * tq + 1] * inv); w.y = pk2(o[d0][4 * tq + 2] * inv, o[d0][4 * tq + 3] * inv);
                *(u32x2*)(op + d0 * 32 + 8 * tq) = w; }
    }
}

__device__ __forceinline__ void attn_diff_phase(const Params& P, LAS unsigned char* lds) {
    constexpr int KS = 272, VS = 320, STAGE = 64 * KS + 64 * VS;
    int tid_ = threadIdx.x; asm volatile("" : "+v"(tid_));
    const int tid = tid_, lane = tid & 63, wave = __builtin_amdgcn_readfirstlane(tid >> 6), r = lane & 31, hi = lane >> 5;
    const int tmap = wave >> 2, sq = wave & 3;
    const bf16_t* Q = (const bf16_t*)(P.ws + WS_Q); const bf16_t* Kg = (const bf16_t*)(P.ws + WS_K); const bf16_t* Vg = (const bf16_t*)(P.ws + WS_V);
    bf16_t* AO = (bf16_t*)(P.ws + WS_AO);
    const float lam = ((const float*)(P.ws + WS_MISC))[0];
    const float* subg = P.in[23];
    const int voff = (4 * hi + ((lane & 15) >> 2)) * VS + (16 * ((lane >> 4) & 1) + 4 * (lane & 3)) * 2;
    const int lkey = tid >> 4, lch = tid & 15;
    LAS float* xch = (LAS float*)lds;
    if (tmap == 0) __builtin_amdgcn_s_setprio(1);
    for (int u = blockIdx.x; u < 2048; u += gridDim.x) {
        const int c = u & 255, i = u >> 8; const int h = c & 7, qb = (c >> 3) & 15, b = i * 2 + (c >> 7);
        const int qrow0 = b * SEQ + qb * 128 + sq * 32;
        bf16x8 qf[4];
        { const bf16_t* qp = Q + (size_t)(qrow0 + r) * DM + (h * 2 + tmap) * 64 + 8 * hi;
#pragma unroll
          for (int d0 = 0; d0 < 4; ++d0) qf[d0] = *(const bf16x8*)(qp + d0 * 16); }
        float m = 0.f, l = 0.f;
        f32x16 o[4], negm;
#pragma unroll
        for (int i2 = 0; i2 < 16; ++i2) { negm[i2] = 0.f;
#pragma unroll
            for (int d = 0; d < 4; ++d) o[d][i2] = 0.f; }
        u32x4 kreg[2], vreg[2];
#define TILE_ROW1(t) ((t) < 32 ? b * SEQ + (t) * 64 : ML + b * CTXL + ((t) - 32) * 64)
#define LOAD_TILE1(t) do { const size_t go = (size_t)(TILE_ROW1(t) + lkey) * DM + h * 128 + lch * 8; kreg[0] = *(const u32x4*)(Kg + go); vreg[0] = *(const u32x4*)(Vg + go); \
                           kreg[1] = *(const u32x4*)(Kg + go + 32 * DM); vreg[1] = *(const u32x4*)(Vg + go + 32 * DM); } while (0)
#define STORE_TILE1(st) do { *(LAS u32x4*)((st) + lkey * KS + lch * 16) = kreg[0]; *(LAS u32x4*)((st) + (lkey + 32) * KS + lch * 16) = kreg[1]; \
                             *(LAS u32x4*)((st) + 64 * KS + lkey * VS + lch * 16) = vreg[0]; *(LAS u32x4*)((st) + 64 * KS + (lkey + 32) * VS + lch * 16) = vreg[1]; } while (0)
#define QK_TILE1(st, a0, a1) do { _Pragma("unroll") for (int d0 = 0; d0 < 4; ++d0) { \
                const bf16x8 k0 = *(const LAS bf16x8*)((st) + r * KS + tmap * 128 + d0 * 32 + hi * 16), k1 = *(const LAS bf16x8*)((st) + (32 + r) * KS + tmap * 128 + d0 * 32 + hi * 16); \
                a0 = MFMA32(k0, qf[d0], d0 == 0 ? negm : a0); a1 = MFMA32(k1, qf[d0], d0 == 0 ? negm : a1); } } while (0)
        LOAD_TILE1(0); STORE_TILE1(lds); LOAD_TILE1(1); STORE_TILE1(lds + STAGE); __syncthreads();
        f32x16 pc0, pc1;
        QK_TILE1(lds, pc0, pc1);
        int oc = 0, on = STAGE, ow = 2 * STAGE;
        for (int t = 0; t < 36; ++t) {
            if (t + 2 < 36) LOAD_TILE1(t + 2);
            f32x16 pn0, pn1;
            QK_TILE1(lds + on, pn0, pn1);
            bf16x8 pb[2][2];
            softmax_tile<4, true>(pc0, pc1, pn0, pn1, negm, m, l, o, pb, t == 0);
            SCHED_FENCE();
            s16x4 vA[2][2];
            pv_load<4, VS>(vA, lds + oc + 64 * KS, voff, 0);
            pv_rest<4, VS>(o, vA, pb, lds + oc + 64 * KS, voff);
            if (t + 2 < 36) STORE_TILE1(lds + ow);
            __syncthreads();
            pc0 = pn0; pc1 = pn1;
            const int tmpo = oc; oc = on; on = ow; ow = tmpo;
        }
#undef QK_TILE1
#undef TILE_ROW1
#undef LOAD_TILE1
#undef STORE_TILE1
        const float inv = (tmap ? lam : 1.f) / half_sum(l);
        if (tmap == 1) {
#pragma unroll
            for (int d0 = 0; d0 < 4; ++d0)
#pragma unroll
                for (int i2 = 0; i2 < 16; ++i2) xch[(sq * 64 + d0 * 16 + i2) * 64 + lane] = o[d0][i2] * inv;
        }
        __syncthreads();
        if (tmap == 0) {
            float ss = 0.f;
#pragma unroll
            for (int d0 = 0; d0 < 4; ++d0)
#pragma unroll
                for (int i2 = 0; i2 < 16; ++i2) { const float v = o[d0][i2] * inv - xch[(sq * 64 + d0 * 16 + i2) * 64 + lane]; o[d0][i2] = v; ss += v * v; }
            ss = half_sum(ss);
            const float rs = (1.f - LAM_INIT) / sqrtf(ss * (1.f / 128.f) + 1e-5f);
            bf16_t* op = AO + (size_t)(qrow0 + r) * DM + h * 128 + 4 * hi;
#pragma unroll
            for (int d0 = 0; d0 < 4; ++d0)
#pragma unroll
                for (int tq = 0; tq < 4; ++tq) { const f32x4 g = *(const f32x4*)(subg + d0 * 32 + 8 * tq + 4 * hi);
                    u32x2 w; w.x = pk2(o[d0][4 * tq] * rs * g.x, o[d0][4 * tq + 1] * rs * g.y); w.y = pk2(o[d0][4 * tq + 2] * rs * g.z, o[d0][4 * tq + 3] * rs * g.w);
                    *(u32x2*)(op + d0 * 32 + 8 * tq) = w; }
        }
        __syncthreads();
    }
    __builtin_amdgcn_s_setprio(0);
}
__global__ void __launch_bounds__(512) fwd_megakernel(Params P) {
    extern __shared__ __attribute__((aligned(16))) unsigned char lds_raw[];
    LAS unsigned char* lds = (LAS unsigned char*)lds_raw;
    cg::grid_group grid = cg::this_grid();
    unsigned char* ws = P.ws;
    float* mod = (float*)(ws + WS_MOD);
    float* XC = (float*)(ws + WS_XC);
    bf16_t* HB = (bf16_t*)(ws + WS_HB);
    bf16_t* Qb = (bf16_t*)(ws + WS_Q); bf16_t* Kb = (bf16_t*)(ws + WS_K); bf16_t* Vb = (bf16_t*)(ws + WS_V); bf16_t* AO = (bf16_t*)(ws + WS_AO);
    bf16_t* HM = (bf16_t*)(ws + WS_HMID);
    const int G = gridDim.x, bid = blockIdx.x;

    unsigned* barw = (unsigned*)(ws + WS_BAR);
    if (bid == 0) for (int i = threadIdx.x; i < XCD_BAR_WORDS; i += 512) barw[i] = 0u;
    if (threadIdx.x < 2) ((LAS unsigned*)(lds + LDS_BARST))[threadIdx.x] = 0u;
    phase_mods(P, lds);
    __syncthreads();
    phase_weights(P, lds);
    grid.sync();
    (void)xcd_barrier_post(barw, (volatile LAS unsigned*)(lds + LDS_BARST));
#define GRID_SYNC() do { XcdBarrier bar_; bar_.bar = (unsigned*)(P.ws + WS_BAR); bar_.x = xb_xcc_id(); bar_.st = (volatile LAS unsigned*)(lds + LDS_BARST); xcd_barrier(bar_); } while (0)
    row_phase<false>(0, MT, 0, G, P.in[0], P.in[2], nullptr, nullptr, nullptr, nullptr, mod, 0, 1, HB);
    GRID_SYNC();

    for (int layer = 0; layer < 2; ++layer) {
        const int Mrows = layer == 0 ? MT : ML;
        const float* modl = mod + (size_t)layer * 17 * NMODC;
        {
            const int KW = layer == 0 ? 128 : DM;
            pg8::Gemm g{HB, (const bf16_t*)(ws + (layer == 0 ? WS_WQKV0 : WS_WQKV1)), MT, DM + 2 * KW, DM};
            pg8::StaticOrder S; S.init(g.M, g.N, G, bid);
            pg8::EpiQKV E{Qb, Kb, Vb, KW, 0.125f * LOG2E};
            pg8::gemm_phase<pg8::EpiQKV, pg8::StaticOrder, true, true>(lds, g, S, E);
        }
        GRID_SYNC();
        if (layer == 0) attn_window_phase(P, lds); else attn_diff_phase(P, lds);
        GRID_SYNC();
        {
            pg8::Gemm g{AO, (const bf16_t*)(ws + (layer == 0 ? WS_WO0 : WS_WO1)), Mrows, DM, DM};
            pg8::StaticOrder S; S.init(g.M, g.N, G, bid);
            pg8::EpiResid E{layer == 0 ? P.in[0] : P.out, layer == 0 ? P.in[2] : XC, P.out, XC, modl + 2 * DM, 0};
            pg8::gemm_phase<pg8::EpiResid, pg8::StaticOrder, true, true>(lds, g, S, E);
        }
        GRID_SYNC();
        row_phase<true>(0, Mrows, 0, G, P.out, XC, P.out, XC, P.in[6] + layer * DM, P.in[7] + layer * DM, modl, 3, 4, HB);
        GRID_SYNC();
        {
            pg8::Gemm g{HB, (const bf16_t*)(ws + (layer == 0 ? WS_W10 : WS_W11)), Mrows, FF, DM};
            pg8::StaticOrder S; S.init(g.M, g.N, G, bid);
            pg8::EpiRelu2 E{HM, FF};
            pg8::gemm_phase<pg8::EpiRelu2, pg8::StaticOrder, true, true>(lds, g, S, E);
        }
        GRID_SYNC();
        {
            pg8::Gemm g{HM, (const bf16_t*)(ws + (layer == 0 ? WS_W20 : WS_W21)), ML, DM, FF};
            pg8::StaticOrder S; S.init(g.M, g.N, G, bid);
            pg8::EpiResid E{P.out, XC, P.out, XC, modl + 5 * DM, 0};
            pg8::gemm_phase<pg8::EpiResid, pg8::StaticOrder, true, true>(lds, g, S, E);
        }
        GRID_SYNC();
        const int NCG = (layer == 0 && G >= 128) ? 64 : 0;
        if (layer == 0) {
            if (bid < NCG || NCG == 0) {
                pg8::Gemm g{HM + (size_t)ML * FF, (const bf16_t*)(ws + WS_W20), MC, DM, FF};
                pg8::StaticOrder S; S.init(g.M, g.N, NCG ? NCG : G, bid);
                pg8::EpiResid E{P.out, XC, P.out, XC, modl + 5 * DM, ML};
                pg8::gemm_phase<pg8::EpiResid, pg8::StaticOrder, true, true>(lds, g, S, E);
            }
            if (NCG == 0) GRID_SYNC();
        }
        row_phase<true>(0, ML, NCG, G - NCG, P.out, XC, P.out, XC, P.in[8] + layer * DM, P.in[9] + layer * DM, modl + 17 * NMODC, 0, 1, layer == 0 ? HB : nullptr);
        if (layer == 0) {
            GRID_SYNC();
            row_phase<true>(ML, MT, 0, G, P.out, XC, P.out, XC, P.in[8] + layer * DM, P.in[9] + layer * DM, modl + 17 * NMODC, 0, 1, HB);
        }
        if (layer == 0) GRID_SYNC();
    }
}

extern "C" void kernel_launch(void* const* d_in, const int* in_sizes, int n_in, void* d_out, int out_size, void* d_ws, size_t ws_size, hipStream_t stream) {
    static int grid_blocks = 0;
    if (grid_blocks == 0) {
        if (n_in != 26 || out_size != ML * DM || ws_size < WS_END) { fprintf(stderr, "kernel_launch: unexpected shapes (n_in %d out %d ws %zu)\n", n_in, out_size, ws_size); grid_blocks = -1; return; }
        int dev = 0, cus = 0, per_cu = 0;
        hipGetDevice(&dev);
        hipDeviceGetAttribute(&cus, hipDeviceAttributeMultiprocessorCount, dev);
        hipFuncSetAttribute((const void*)fwd_megakernel, hipFuncAttributeMaxDynamicSharedMemorySize, LDS_BYTES);
        hipOccupancyMaxActiveBlocksPerMultiprocessor(&per_cu, (const void*)fwd_megakernel, 512, LDS_BYTES);
        if (per_cu < 1) { fprintf(stderr, "kernel_launch: occupancy query reports %d blocks per CU\n", per_cu); per_cu = 1; }
        grid_blocks = cus * per_cu;
        (void)hipGetLastError();
    }
    if (grid_blocks < 0) return;
    Params p{};
    for (int i = 0; i < 26; ++i) p.in[i] = (const float*)d_in[i];
    p.out = (float*)d_out; p.ws = (unsigned char*)d_ws;
    void* args[] = {&p};
    hipError_t e = hipLaunchCooperativeKernel((const void*)fwd_megakernel, dim3(grid_blocks), dim3(512), args, LDS_BYTES, stream);
    if (e != hipSuccess) fprintf(stderr, "cooperative launch failed: %s (grid %d)\n", hipGetErrorString(e), grid_blocks);
}
```
